# Optimizing an MI355X kernel written in HIP

```python
import math
import jax, jax.numpy as jnp
from jax import lax
import numpy as np

D_MODEL = 1024
BATCH = 1
SEQ = 16384
DEPTH = 1

MLA_HEADS = 8
QK_NOPE_DIM = 128
QK_ROPE_DIM = 64
V_HEAD_DIM = 128
Q_LORA_RANK = 384
KV_LORA_RANK = 256
MLA_WIDTH = MLA_HEADS * V_HEAD_DIM
QK_HEAD_DIM = QK_NOPE_DIM + QK_ROPE_DIM
ROPE_THETA = 10000.0
ATTN_BLOCK = 128

SSM_HEAD_DIM = 64
SSM_HEADS = 16
SSM_WIDTH = SSM_HEADS * SSM_HEAD_DIM
SSM_GROUPS = 2
SSM_STATE = 128
CONV_WIDTH = 4
CHUNK = 128
CONV_CH = SSM_WIDTH + 2 * SSM_GROUPS * SSM_STATE

MIX_WIDTH = MLA_WIDTH + SSM_WIDTH

IN_SPLITS = (Q_LORA_RANK, KV_LORA_RANK + QK_ROPE_DIM, MLA_WIDTH, CONV_CH, SSM_HEADS, SSM_WIDTH)
IN_WIDTH = sum(IN_SPLITS)

DEEPNORM_ALPHA = (2.0 * DEPTH) ** 0.25
DEEPNORM_BETA = (8.0 * DEPTH) ** -0.25
RMS_EPS = 1e-6
LN_EPS = 1e-5

kernel_name = "hybrid_mla_ssd_parallel_heads_deepnorm_adaln"


def split_last(x, sizes):
    out, start = [], 0
    for s in sizes:
        out.append(x[..., start:start + s])
        start += s
    return out


def rms_norm(x, g):
    xf = x.astype(jnp.float32)
    y = xf * lax.rsqrt(jnp.mean(xf * xf, axis=-1, keepdims=True) + RMS_EPS)
    return (y * g.astype(jnp.float32)).astype(x.dtype)


def layer_norm(x, g, b):
    xf = x.astype(jnp.float32)
    mu = jnp.mean(xf, axis=-1, keepdims=True)
    var = jnp.mean(jnp.square(xf - mu), axis=-1, keepdims=True)
    y = (xf - mu) * lax.rsqrt(var + LN_EPS)
    return (y * g.astype(jnp.float32) + b.astype(jnp.float32)).astype(x.dtype)


def apply_rope(x, positions):
    half = QK_ROPE_DIM // 2
    inv_freq = 1.0 / (ROPE_THETA ** (jnp.arange(half, dtype=jnp.float32) / half))
    ang = positions.astype(jnp.float32)[..., None] * inv_freq
    cos = jnp.cos(ang)[:, :, None, :]
    sin = jnp.sin(ang)[:, :, None, :]
    xf = x.astype(jnp.float32)
    x1, x2 = xf[..., :half], xf[..., half:]
    out = jnp.concatenate([x1 * cos - x2 * sin, x2 * cos + x1 * sin], axis=-1)
    return out.astype(x.dtype)


def causal_block_attention(q, k, v, scale):
    b, s, h, dq = q.shape
    nb = s // ATTN_BLOCK
    qb = q.reshape(b, nb, ATTN_BLOCK, h, dq).transpose(1, 0, 2, 3, 4)
    key_pos = jnp.arange(s)

    def one_block(args):
        q_blk, i = args
        sc = jnp.einsum('bqhd,bkhd->bhqk', q_blk, k,
                        preferred_element_type=jnp.float32) * scale
        q_pos = i * ATTN_BLOCK + jnp.arange(ATTN_BLOCK)
        mask = key_pos[None, :] <= q_pos[:, None]
        sc = jnp.where(mask[None, None], sc, -jnp.inf)
        p = jax.nn.softmax(sc, axis=-1).astype(v.dtype)
        return jnp.einsum('bhqk,bkhd->bqhd', p, v)

    out = lax.map(one_block, (qb, jnp.arange(nb)))
    return out.transpose(1, 0, 2, 3, 4).reshape(b, s, h, v.shape[-1])


def mla_branch(q_lat, kv_lat, positions, q_norm_g, w_qb, kv_norm_g, w_kvb):
    b, s, _ = q_lat.shape
    q = (rms_norm(q_lat, q_norm_g) @ w_qb).reshape(b, s, MLA_HEADS, QK_HEAD_DIM)
    q_nope, q_rope = q[..., :QK_NOPE_DIM], q[..., QK_NOPE_DIM:]
    c_kv, k_rope = kv_lat[..., :KV_LORA_RANK], kv_lat[..., KV_LORA_RANK:]
    kv = (rms_norm(c_kv, kv_norm_g) @ w_kvb).reshape(b, s, MLA_HEADS, QK_NOPE_DIM + V_HEAD_DIM)
    k_nope, v = kv[..., :QK_NOPE_DIM], kv[..., QK_NOPE_DIM:]
    q_rope = apply_rope(q_rope, positions)
    k_rope = apply_rope(k_rope[:, :, None, :], positions)
    q = jnp.concatenate([q_nope, q_rope], axis=-1)
    k = jnp.concatenate([k_nope, jnp.broadcast_to(k_rope, (b, s, MLA_HEADS, QK_ROPE_DIM))], axis=-1)
    o = causal_block_attention(q, k, v, QK_HEAD_DIM ** -0.5)
    return o.reshape(b, s, MLA_WIDTH)


def causal_depthwise_conv(x, w, bias):
    out = lax.conv_general_dilated(
        x, w[:, None, :], window_strides=(1,), padding=[(CONV_WIDTH - 1, 0)],
        dimension_numbers=('NWC', 'WIO', 'NWC'), feature_group_count=x.shape[-1])
    return out + bias


def ssd_chunked(x, da, bm, cm):
    out_dtype = x.dtype
    b, s, h, p = x.shape
    nc, r = s // CHUNK, h // SSM_GROUPS
    f32 = jnp.float32
    X = x.astype(f32).reshape(b, nc, CHUNK, SSM_GROUPS, r, p)
    A = da.astype(f32).reshape(b, nc, CHUNK, SSM_GROUPS, r)
    Bc = bm.astype(f32).reshape(b, nc, CHUNK, SSM_GROUPS, SSM_STATE)
    Cc = cm.astype(f32).reshape(b, nc, CHUNK, SSM_GROUPS, SSM_STATE)
    a_cum = jnp.cumsum(A, axis=2)
    seg = a_cum[:, :, :, None] - a_cum[:, :, None, :]
    tri = jnp.tril(jnp.ones((CHUNK, CHUNK), dtype=bool))[:, :, None, None]
    decay = jnp.exp(jnp.where(tri, seg, -jnp.inf))
    cb = jnp.einsum('bclgn,bcsgn->bclsg', Cc, Bc)
    y_diag = jnp.einsum('bclsgr,bcsgrp->bclgrp', cb[..., None] * decay, X)
    decay_to_end = jnp.exp(a_cum[:, :, -1:] - a_cum)
    states = jnp.einsum('bclgn,bclgr,bclgrp->bcgrpn', Bc, decay_to_end, X)
    chunk_decay = jnp.exp(a_cum[:, :, -1])

    def step(hc, inp):
        st, dc = inp
        return hc * dc[..., None, None] + st, hc

    h0 = jnp.zeros((b, SSM_GROUPS, r, p, SSM_STATE), f32)
    _, prev = lax.scan(step, h0, (states.transpose(1, 0, 2, 3, 4, 5),
                                   chunk_decay.transpose(1, 0, 2, 3)))
    prev = prev.transpose(1, 0, 2, 3, 4, 5)
    y_off = jnp.einsum('bclgn,bcgrpn,bclgr->bclgrp', Cc, prev, jnp.exp(a_cum))
    return (y_diag + y_off).reshape(b, s, h, p).astype(out_dtype)


def ssd_branch(xbc_raw, dt_raw, z, conv_w, conv_b, dt_bias, a_log, d_skip, ssm_norm_g):
    b, s, _ = xbc_raw.shape
    xbc = jax.nn.silu(causal_depthwise_conv(xbc_raw, conv_w, conv_b))
    xs, bm, cm = split_last(xbc, (SSM_WIDTH, SSM_GROUPS * SSM_STATE, SSM_GROUPS * SSM_STATE))
    xs = xs.reshape(b, s, SSM_HEADS, SSM_HEAD_DIM)
    bm = bm.reshape(b, s, SSM_GROUPS, SSM_STATE)
    cm = cm.reshape(b, s, SSM_GROUPS, SSM_STATE)
    dt = jax.nn.softplus(dt_raw.astype(jnp.float32) + dt_bias.astype(jnp.float32))
    a = -jnp.exp(a_log.astype(jnp.float32))
    y = ssd_chunked(xs * dt[..., None].astype(xs.dtype), dt * a, bm, cm)
    y = y + xs * d_skip[:, None]
    hf = (y.reshape(b, s, SSM_WIDTH).astype(jnp.float32)
          * jax.nn.silu(z.astype(jnp.float32))).reshape(b, s, SSM_GROUPS, -1)
    hf = hf * lax.rsqrt(jnp.mean(hf * hf, axis=-1, keepdims=True) + RMS_EPS)
    return (hf.reshape(b, s, SSM_WIDTH) * ssm_norm_g.astype(jnp.float32)).astype(xbc_raw.dtype)


def hybrid_layer(x, c, positions, w_ada, b_ada, w_in, q_norm_g, w_qb, kv_norm_g, w_kvb,
                 conv_w, conv_b, dt_bias, a_log, d_skip, ssm_norm_g, w_out, ln_g, ln_b):
    mod = c @ w_ada + b_ada
    shift, scale, gate = mod[:, :D_MODEL], mod[:, D_MODEL:2 * D_MODEL], mod[:, 2 * D_MODEL:]
    u = x * (1.0 + scale[:, None, :]) + shift[:, None, :]
    proj = u @ w_in
    q_lat, kv_lat, z_attn, xbc, dt_raw, z_ssm = split_last(proj, IN_SPLITS)
    o_attn = mla_branch(q_lat, kv_lat, positions, q_norm_g, w_qb, kv_norm_g, w_kvb) * jax.nn.silu(z_attn)
    o_ssm = ssd_branch(xbc, dt_raw, z_ssm, conv_w, conv_b, dt_bias, a_log, d_skip, ssm_norm_g)
    mixed = jnp.concatenate([o_attn, o_ssm], axis=-1) @ w_out
    return layer_norm(DEEPNORM_ALPHA * x + gate[:, None, :] * mixed, ln_g, ln_b)


def setup_inputs(seed: int = 0) -> dict:
    key = jax.random.key(seed)
    ks = jax.random.split(key, 20)
    f32 = jnp.float32
    n = lambda k, shape, s: jax.random.normal(k, shape, f32) * s
    L = DEPTH
    dt0 = jnp.exp(jax.random.uniform(ks[12], (L, SSM_HEADS), f32, math.log(1e-3), math.log(1e-1)))
    return {
        "x": jax.random.normal(ks[0], (BATCH, SEQ, D_MODEL), f32),
        "c": jax.random.normal(ks[1], (BATCH, D_MODEL), f32),
        "positions": jnp.broadcast_to(jnp.arange(SEQ, dtype=jnp.int32), (BATCH, SEQ)),
        "w_ada": n(ks[2], (L, D_MODEL, 3 * D_MODEL), 0.5 * D_MODEL ** -0.5),
        "b_ada": n(ks[3], (L, 3 * D_MODEL), 0.02),
        "w_in": n(ks[4], (L, D_MODEL, IN_WIDTH), D_MODEL ** -0.5),
        "q_norm_g": 1.0 + n(ks[5], (L, Q_LORA_RANK), 0.05),
        "w_qb": n(ks[6], (L, Q_LORA_RANK, MLA_HEADS * QK_HEAD_DIM), Q_LORA_RANK ** -0.5),
        "kv_norm_g": 1.0 + n(ks[7], (L, KV_LORA_RANK), 0.05),
        "w_kvb": n(ks[8], (L, KV_LORA_RANK, MLA_HEADS * (QK_NOPE_DIM + V_HEAD_DIM)), KV_LORA_RANK ** -0.5),
        "conv_w": n(ks[9], (L, CONV_WIDTH, CONV_CH), CONV_WIDTH ** -0.5),
        "conv_b": n(ks[10], (L, CONV_CH), 0.02),
        "dt_bias": dt0 + jnp.log(-jnp.expm1(-dt0)),
        "a_log": jnp.log(jax.random.uniform(ks[13], (L, SSM_HEADS), f32, 1.0, 16.0)),
        "d_skip": 1.0 + n(ks[14], (L, SSM_HEADS), 0.1),
        "ssm_norm_g": 1.0 + n(ks[15], (L, SSM_WIDTH), 0.05),
        "w_out": n(ks[16], (L, MIX_WIDTH, D_MODEL), DEEPNORM_BETA * MIX_WIDTH ** -0.5),
        "ln_g": 1.0 + n(ks[17], (L, D_MODEL), 0.05),
        "ln_b": n(ks[18], (L, D_MODEL), 0.02),
    }


def reference(x, c, positions, w_ada, b_ada, w_in, q_norm_g, w_qb, kv_norm_g, w_kvb,
              conv_w, conv_b, dt_bias, a_log, d_skip, ssm_norm_g, w_out, ln_g, ln_b):
    h = x
    for l in range(DEPTH):
        h = hybrid_layer(h, c, positions, w_ada[l], b_ada[l], w_in[l], q_norm_g[l], w_qb[l],
                         kv_norm_g[l], w_kvb[l], conv_w[l], conv_b[l], dt_bias[l], a_log[l],
                         d_skip[l], ssm_norm_g[l], w_out[l], ln_g[l], ln_b[l])
    return h
```

```cpp
#include <hip/hip_runtime.h>
#include <hip/hip_cooperative_groups.h>
#include <cstdio>
#include <cmath>
namespace cg = cooperative_groups;

#ifndef MULTI
#define MULTI 0
#endif

typedef unsigned short bf16_t;
typedef __attribute__((ext_vector_type(8))) short bf16x8;
typedef __attribute__((ext_vector_type(4))) short bf16x4;
typedef __attribute__((ext_vector_type(16))) float f32x16;
typedef __attribute__((ext_vector_type(2))) __bf16 bf2_t;
typedef __attribute__((ext_vector_type(2))) float f2_t;
typedef __attribute__((ext_vector_type(4))) unsigned u32x4;
typedef __attribute__((ext_vector_type(2))) unsigned u32x2;
#define DI __device__ __forceinline__
#define MFMA32(a, b, c) __builtin_amdgcn_mfma_f32_32x32x16_bf16((a), (b), (c), 0, 0, 0)

constexpr int S = 16384;
constexpr int NTHREADS = 256;
constexpr int SMEM_BYTES = 61504;
constexpr float QSCALE = 0.07216878364870322f * 1.4426950408889634f;
constexpr float DN_ALPHA = 1.189207115002721f;

struct Params {
  const float *x, *c; const int* pos;
  const float *w_ada, *b_ada, *w_in, *q_g, *w_qb, *kv_g, *w_kvb, *conv_w, *conv_b, *dt_bias, *a_log, *d_skip, *ssm_g, *w_out, *ln_g, *ln_b;
  float* out;
  bf16_t *u, *lat, *xbc, *mix, *Q, *Kk, *VT, *states, *w_inT, *w_qbT, *w_kvbT, *w_outT;
  float *dt_raw, *modp, *mod, *cdecay;
  float2* cs;
  int* counters;
  unsigned* bar;
  int probe; int pad0;
  float inv_freq[32];
};

DI unsigned pk2(float a, float b) { f2_t v = {a, b}; bf2_t r = __builtin_convertvector(v, bf2_t); return __builtin_bit_cast(unsigned, r); }
DI bf16_t f2bf(float a) { return (bf16_t)(pk2(a, 0.f) & 0xffffu); }
DI float bf2f(unsigned h) { return __uint_as_float(h << 16); }
DI float bflo(unsigned w) { return __uint_as_float(w << 16); }
DI float bfhi(unsigned w) { return __uint_as_float(w & 0xffff0000u); }
DI int crow(int reg, int h) { return (reg & 3) + 8 * (reg >> 2) + 4 * h; }
DI float silu_f(float x) { return x * __builtin_amdgcn_rcpf(1.f + __expf(-x)); }
DI float softplus_f(float x) { return fmaxf(x, 0.f) + log1pf(__expf(-fabsf(x))); }
DI bf16x8 pack8(const f32x16& x, int s) {
  u32x4 p;
  p.x = pk2(x[8 * s + 0], x[8 * s + 1]); p.y = pk2(x[8 * s + 2], x[8 * s + 3]);
  p.z = pk2(x[8 * s + 4], x[8 * s + 5]); p.w = pk2(x[8 * s + 6], x[8 * s + 7]);
  return __builtin_bit_cast(bf16x8, p);
}
DI int otid() { int t = threadIdx.x; asm volatile("" : "+v"(t)); return t; }
DI float xhalf_max(float v) {
  auto r = __builtin_amdgcn_permlane32_swap(__float_as_uint(v), __float_as_uint(v), false, false);
  return fmaxf(__uint_as_float(r[0]), __uint_as_float(r[1]));
}
DI f32x16 zero16() { f32x16 z; _Pragma("unroll") for (int i = 0; i < 16; ++i) z[i] = 0.f; return z; }


#define XB_TMO      128
#define XB_XCNT(j)  (256  + 64 * (j))
#define XB_XSUB(j)  (1280 + 64 * (j))
#define XB_XGEN(j)  (2304 + 64 * (j))
#define XB_TOP      3328
#define XB_TOPGEN   3392
#define XCD_BAR_WORDS 3456
#define XB_SPIN_CAP (1u << 22)
#define LAS __attribute__((address_space(3)))
DI unsigned xb_ld(unsigned* p)              { return __hip_atomic_load(p, __ATOMIC_RELAXED, __HIP_MEMORY_SCOPE_AGENT); }
DI unsigned xb_add(unsigned* p, unsigned v) { return __hip_atomic_fetch_add(p, v, __ATOMIC_RELAXED, __HIP_MEMORY_SCOPE_AGENT); }
DI unsigned xb_xcc_id() { return (unsigned)__builtin_amdgcn_s_getreg((3 << 11) | 20) & 0xFu; }
#define XB_SPIN(cond, bar) do { unsigned _sp = 0; while (cond) { __builtin_amdgcn_s_sleep(1); \
    if ((++_sp & 255u) == 0u) { if (xb_ld(&(bar)[XB_TMO])) break; if (_sp > XB_SPIN_CAP) { atomicAdd(&(bar)[XB_TMO], 1u); break; } } } } while (0)
struct XcdBarrier { unsigned* bar; unsigned x; volatile LAS unsigned* st; };
DI XcdBarrier xcd_barrier_post(unsigned* bar, volatile LAS unsigned* st) {
  XcdBarrier b; b.bar = bar; b.x = xb_xcc_id(); b.st = st;
  if (threadIdx.x == 0) (void)xb_add(&bar[XB_XCNT(b.x)], 1u);
  return b;
}
DI void xcd_barrier_complete(unsigned* bar, unsigned x, unsigned& nloc, unsigned& nx) {
  const unsigned G = gridDim.x * gridDim.y * gridDim.z;
  unsigned sum, cnt, mine, sp = 0u;
  for (;;) {
    sum = 0u; cnt = 0u; mine = 0u;
    _Pragma("unroll") for (unsigned j = 0; j < 16; ++j) { const unsigned c = xb_ld(&bar[XB_XCNT(j)]); sum += c; cnt += (c > 0u) ? 1u : 0u; mine = (j == x) ? c : mine; }
    if (sum == G) break;
    __builtin_amdgcn_s_sleep(1);
    if ((++sp & 255u) == 0u) { if (xb_ld(&bar[XB_TMO])) break; if (sp > XB_SPIN_CAP) { atomicAdd(&bar[XB_TMO], 1u); break; } }
  }
  nloc = mine > 0u ? mine : 1u; nx = cnt > 0u ? cnt : 1u;
}
DI void xcd_barrier(const XcdBarrier& b) {
  asm volatile("s_waitcnt vmcnt(0)" ::: "memory");
  __syncthreads();
  if (threadIdx.x == 0) {
    unsigned* bar = b.bar;
    __builtin_amdgcn_s_waitcnt(0);
    unsigned nloc = b.st[0], nx = b.st[1];
    if (nloc == 0u) { xcd_barrier_complete(bar, b.x, nloc, nx); b.st[0] = nloc; b.st[1] = nx; }
    const unsigned old = xb_add(&bar[XB_XSUB(b.x)], 1u);
    const unsigned gen = old / nloc;
    if (old + 1u == (gen + 1u) * nloc) {
      __builtin_amdgcn_fence(__ATOMIC_RELEASE, "agent");
      asm volatile("s_waitcnt vmcnt(0)" ::: "memory");
      const unsigned og = xb_add(&bar[XB_TOP], 1u);
      const unsigned tg = og / nx;
      if (og + 1u == (tg + 1u) * nx) xb_add(&bar[XB_TOPGEN], 1u);
      else XB_SPIN(xb_ld(&bar[XB_TOPGEN]) == tg, bar);
      __builtin_amdgcn_fence(__ATOMIC_ACQUIRE, "agent");
      xb_add(&bar[XB_XGEN(b.x)], 1u);
      asm volatile("s_waitcnt vmcnt(0)" ::: "memory");
    } else {
      XB_SPIN(xb_ld(&bar[XB_XGEN(b.x)]) == gen, bar);
      __builtin_amdgcn_fence(__ATOMIC_ACQUIRE, "agent");
      asm volatile("s_waitcnt vmcnt(0)" ::: "memory");
    }
  }
  __syncthreads();
}

constexpr int GS = 72;
DI float sumsq8(u32x4 v) {
  float s = 0.f, f;
  f = bflo(v.x); s += f * f; f = bfhi(v.x); s += f * f;
  f = bflo(v.y); s += f * f; f = bfhi(v.y); s += f * f;
  f = bflo(v.z); s += f * f; f = bfhi(v.z); s += f * f;
  f = bflo(v.w); s += f * f; f = bfhi(v.w); s += f * f;
  return s;
}
template <bool SS = false, class Epi>
DI void gemm128(const bf16_t* __restrict__ A, int lda, const bf16_t* __restrict__ Bt, int ldb, int K, int m0, int n0,
                char* smem, Epi&& epi, float* rn = nullptr) {
  bf16_t* sA = (bf16_t*)smem;
  bf16_t* sB = sA + 128 * GS;
  const int tid = otid(), lane = tid & 63, wave = __builtin_amdgcn_readfirstlane(tid >> 6);
  const int r = lane & 31, h = lane >> 5;
  const int wm = wave >> 1, wn = wave & 1;
  f32x16 acc[2][2];
  _Pragma("unroll") for (int i = 0; i < 2; ++i) _Pragma("unroll") for (int j = 0; j < 2; ++j) acc[i][j] = zero16();
  const int lrow = tid >> 3, lcc = tid & 7;
  const bf16_t* Ag = A + (size_t)(m0 + lrow) * lda + lcc * 8;
  const bf16_t* Bg = Bt + (size_t)(n0 + lrow) * ldb + lcc * 8;
  u32x4 ra[4], rb[4];
  _Pragma("unroll") for (int i = 0; i < 4; ++i) {
    ra[i] = *(const u32x4*)(Ag + (size_t)(32 * i) * lda);
    rb[i] = *(const u32x4*)(Bg + (size_t)(32 * i) * ldb);
  }
  const int nk = K >> 6;
  float ssq[4] = {0.f, 0.f, 0.f, 0.f};
  for (int kt = 0; kt < nk; ++kt) {
    __syncthreads();
    _Pragma("unroll") for (int i = 0; i < 4; ++i) {
      *(u32x4*)(sA + (lrow + 32 * i) * GS + lcc * 8) = ra[i];
      *(u32x4*)(sB + (lrow + 32 * i) * GS + lcc * 8) = rb[i];
      if (SS) ssq[i] += sumsq8(ra[i]);
    }
    __syncthreads();
    if (kt + 1 < nk) {
      _Pragma("unroll") for (int i = 0; i < 4; ++i) {
        ra[i] = *(const u32x4*)(Ag + (size_t)(32 * i) * lda + (kt + 1) * 64);
        rb[i] = *(const u32x4*)(Bg + (size_t)(32 * i) * ldb + (kt + 1) * 64);
      }
    }
    _Pragma("unroll") for (int kk = 0; kk < 4; ++kk) {
      bf16x8 a0 = *(const bf16x8*)(sA + (wm * 64 + r) * GS + kk * 16 + h * 8);
      bf16x8 a1 = *(const bf16x8*)(sA + (wm * 64 + 32 + r) * GS + kk * 16 + h * 8);
      bf16x8 b0 = *(const bf16x8*)(sB + (wn * 64 + r) * GS + kk * 16 + h * 8);
      bf16x8 b1 = *(const bf16x8*)(sB + (wn * 64 + 32 + r) * GS + kk * 16 + h * 8);
      acc[0][0] = MFMA32(a0, b0, acc[0][0]);
      acc[0][1] = MFMA32(a0, b1, acc[0][1]);
      acc[1][0] = MFMA32(a1, b0, acc[1][0]);
      acc[1][1] = MFMA32(a1, b1, acc[1][1]);
    }
  }
  if (SS) {
    _Pragma("unroll") for (int i = 0; i < 4; ++i) {
      float v = ssq[i];
      v += __shfl_xor(v, 1); v += __shfl_xor(v, 2); v += __shfl_xor(v, 4);
      if (lcc == 0) rn[lrow + 32 * i] = rsqrtf(v / (float)K + 1e-6f);
    }
  }
  __syncthreads();
  epi(acc, wm, wn, r, h);
}

template <class Epi>
DI void gemm256(const bf16_t* __restrict__ A, int lda, const bf16_t* __restrict__ Bt, int ldb, int K, int m0, int n0,
                char* smem, Epi&& epi) {
  bf16_t* sA = (bf16_t*)smem;
  bf16_t* sB = sA + 256 * GS;
  const int tid = otid(), lane = tid & 63, wave = __builtin_amdgcn_readfirstlane(tid >> 6);
  const int r = lane & 31, h = lane >> 5;
  f32x16 acc[2][4];
  _Pragma("unroll") for (int i = 0; i < 2; ++i) _Pragma("unroll") for (int j = 0; j < 4; ++j) acc[i][j] = zero16();
  const int lrow = tid >> 3, lcc = tid & 7;
  const bf16_t* Ag = A + (size_t)(m0 + lrow) * lda + lcc * 8;
  const bf16_t* Bg = Bt + (size_t)(n0 + lrow) * ldb + lcc * 8;
  u32x4 ra[8], rb[4];
  _Pragma("unroll") for (int i = 0; i < 8; ++i) ra[i] = *(const u32x4*)(Ag + (size_t)(32 * i) * lda);
  _Pragma("unroll") for (int i = 0; i < 4; ++i) rb[i] = *(const u32x4*)(Bg + (size_t)(32 * i) * ldb);
  const int nk = K >> 6;
  for (int kt = 0; kt < nk; ++kt) {
    __syncthreads();
    _Pragma("unroll") for (int i = 0; i < 8; ++i) *(u32x4*)(sA + (lrow + 32 * i) * GS + lcc * 8) = ra[i];
    _Pragma("unroll") for (int i = 0; i < 4; ++i) *(u32x4*)(sB + (lrow + 32 * i) * GS + lcc * 8) = rb[i];
    __syncthreads();
    if (kt + 1 < nk) {
      _Pragma("unroll") for (int i = 0; i < 8; ++i) ra[i] = *(const u32x4*)(Ag + (size_t)(32 * i) * lda + (kt + 1) * 64);
      _Pragma("unroll") for (int i = 0; i < 4; ++i) rb[i] = *(const u32x4*)(Bg + (size_t)(32 * i) * ldb + (kt + 1) * 64);
    }
    _Pragma("unroll") for (int kk = 0; kk < 4; ++kk) {
      bf16x8 a0 = *(const bf16x8*)(sA + (wave * 64 + r) * GS + kk * 16 + h * 8);
      bf16x8 a1 = *(const bf16x8*)(sA + (wave * 64 + 32 + r) * GS + kk * 16 + h * 8);
      _Pragma("unroll") for (int ni = 0; ni < 4; ++ni) {
        bf16x8 b = *(const bf16x8*)(sB + (ni * 32 + r) * GS + kk * 16 + h * 8);
        acc[0][ni] = MFMA32(a0, b, acc[0][ni]);
        acc[1][ni] = MFMA32(a1, b, acc[1][ni]);
      }
    }
  }
  __syncthreads();
  epi(acc, wave, r, h);
}

constexpr int CS = 136;
DI void stage_vals(bf16_t* sC, const f32x16 (&acc)[2][2], int wm, int wn, int r, int h) {
  _Pragma("unroll") for (int mi = 0; mi < 2; ++mi) _Pragma("unroll") for (int ni = 0; ni < 2; ++ni)
    _Pragma("unroll") for (int reg = 0; reg < 16; ++reg)
      sC[(wm * 64 + mi * 32 + crow(reg, h)) * CS + wn * 64 + ni * 32 + r] = f2bf(acc[mi][ni][reg]);
}
template <class W>
DI void drain_rows(const bf16_t* sC, W&& wr) {
  const int tid = otid();
  _Pragma("unroll") for (int i = 0; i < 8; ++i) {
    int c = tid + 256 * i, row = c >> 4, cc = c & 15;
    u32x4 v = *(const u32x4*)(sC + row * CS + cc * 8);
    wr(row, cc * 8, v);
  }
}

DI void transpose_tile(const float* __restrict__ src, int N, bf16_t* __restrict__ dst, int K, const float* __restrict__ g,
                       int kt, int nt, int mode, char* smem) {
  bf16_t* t = (bf16_t*)smem;
  const int tid = otid(), tx = tid & 63, ty = tid >> 6;
  const int k0 = kt * 64, n0 = nt * 64;
  int nd = n0 + tx, sc = nd;
  bool ok = true;
  if (mode == 1) {
    if (nd < 3264) sc = nd; else if (nd < 4288) sc = nd + 16; else if (nd < 4304) sc = nd - 4288 + 3264; else ok = false;
  }
  __syncthreads();
  float v[16], gv[16];
  if (!ok) sc = 0;
  _Pragma("unroll") for (int i = 0; i < 16; ++i) v[i] = src[(size_t)(k0 + ty + 4 * i) * N + sc];
  if (g) { _Pragma("unroll") for (int i = 0; i < 16; ++i) gv[i] = g[k0 + ty + 4 * i]; }
  else   { _Pragma("unroll") for (int i = 0; i < 16; ++i) gv[i] = 1.f; }
  _Pragma("unroll") for (int i = 0; i < 16; ++i) t[tx * 72 + ty + 4 * i] = f2bf(ok ? v[i] * gv[i] : 0.f);
  __syncthreads();
  const int nl = tid >> 2, kc = (tid & 3) * 16;
  u32x4 v0 = *(const u32x4*)(t + nl * 72 + kc), v1 = *(const u32x4*)(t + nl * 72 + kc + 8);
  bf16_t* d = dst + (size_t)(n0 + nl) * K + k0 + kc;
  *(u32x4*)d = v0; *(u32x4*)(d + 8) = v1;
}

DI void phase0(const Params& p, char* smem) {
  const int nb = gridDim.x, bid = blockIdx.x, tid = otid();
  if (bid == 0 && tid < 64) p.counters[tid] = 0;
  float* red = (float*)smem;
  for (int it = bid; it < 192; it += nb) {
    const int col = it * 16 + (tid & 15), kg = tid >> 4;
    const float* w = p.w_ada + (size_t)(kg * 64) * 3072 + col;
    float s = 0.f;
    _Pragma("unroll") for (int k = 0; k < 64; ++k) s += p.c[kg * 64 + k] * w[(size_t)k * 3072];
    __syncthreads();
    red[tid] = s;
    __syncthreads();
    if (tid < 16) {
      float t = p.b_ada[col];
      _Pragma("unroll") for (int j = 0; j < 16; ++j) t += red[j * 16 + tid];
      p.mod[col] = t;
    }
  }
}

DI void phase0b(const Params& p, char* smem) {
  const int nb = gridDim.x, bid = blockIdx.x, tid = otid();
  constexpr int I_U = 512, I_WIN = 68 * 16, I_WQB = 24 * 6, I_WKV = 32 * 4, I_WOUT = 16 * 32, I_ROPE = 512;
  constexpr int TOTAL = I_U + I_WIN + I_WQB + I_WKV + I_WOUT + I_ROPE;
  for (int it0 = bid; it0 < TOTAL; it0 += nb) {
    int it = it0;
    if (it < I_U) {
      int c0 = (tid & 127) * 8; const int rsub = tid >> 7;
      asm volatile("" : "+v"(c0));
      float sc[8], sh[8];
      _Pragma("unroll") for (int e = 0; e < 8; ++e) {
        sh[e] = p.mod[c0 + e]; sc[e] = 1.f + p.mod[1024 + c0 + e];
      }
      _Pragma("unroll 1") for (int i0 = 0; i0 < 16; i0 += 8) {
        float4 xa[8], xb[8];
        _Pragma("unroll") for (int j = 0; j < 8; ++j) {
          const float4* xp = (const float4*)(p.x + (size_t)(it * 32 + 2 * (i0 + j) + rsub) * 1024 + c0);
          xa[j] = xp[0]; xb[j] = xp[1];
        }
        _Pragma("unroll") for (int j = 0; j < 8; ++j) {
          const float4 a = xa[j], b = xb[j];
          u32x4 o;
          o.x = pk2(a.x * sc[0] + sh[0], a.y * sc[1] + sh[1]);
          o.y = pk2(a.z * sc[2] + sh[2], a.w * sc[3] + sh[3]);
          o.z = pk2(b.x * sc[4] + sh[4], b.y * sc[5] + sh[5]);
          o.w = pk2(b.z * sc[6] + sh[6], b.w * sc[7] + sh[7]);
          *(u32x4*)(p.u + (size_t)(it * 32 + 2 * (i0 + j) + rsub) * 1024 + c0) = o;
        }
      }
      continue;
    }
    it -= I_U;
    if (it < I_WIN) { transpose_tile(p.w_in, 4304, p.w_inT, 1024, nullptr, it % 16, it / 16, 1, smem); continue; }
    it -= I_WIN;
    if (it < I_WQB) { transpose_tile(p.w_qb, 1536, p.w_qbT, 384, p.q_g, it % 6, it / 6, 0, smem); continue; }
    it -= I_WQB;
    if (it < I_WKV) { transpose_tile(p.w_kvb, 2048, p.w_kvbT, 256, p.kv_g, it % 4, it / 4, 0, smem); continue; }
    it -= I_WKV;
    if (it < I_WOUT) { transpose_tile(p.w_out, 1024, p.w_outT, 2048, nullptr, it % 32, it / 32, 0, smem); continue; }
    it -= I_WOUT;
    _Pragma("unroll") for (int j = 0; j < 4; ++j) {
      int e = (it * 4 + j) * 256 + tid, sidx = e >> 5, i = e & 31;
      float ang = (float)p.pos[sidx] * p.inv_freq[i];
      double t = (double)ang * 0.15915494309189535;
      t -= rint(t);
      float f = (float)t;
      p.cs[e] = make_float2(__builtin_amdgcn_cosf(f), __builtin_amdgcn_sinf(f));
    }
  }
}

DI void route_store(const Params& p, size_t rg, int n, u32x4 v) {
  bf16_t* d;
  if (n < 704) d = p.lat + rg * 704 + n;
  else if (n < 1728) d = p.mix + rg * 2048 + (n - 704);
  else if (n < 3264) d = p.xbc + rg * 1536 + (n - 1728);
  else if (n < 4288) d = p.mix + rg * 2048 + 1024 + (n - 3264);
  else return;
  *(u32x4*)d = v;
}
DI void phase1(const Params& p, char* smem) {
  const int xl = blockIdx.x & 7, local = blockIdx.x >> 3, nl = gridDim.x >> 3;
  for (int t = local; t < 256; t += nl) {
    const int m0 = (8 * xl + (t & 7)) * 256, n0 = (t >> 3) * 128;
    gemm256(p.u, 1024, p.w_inT, 1024, 1024, m0, n0, smem,
      [&](const f32x16 (&acc)[2][4], int w, int r, int h) {
        bf16_t* sC = (bf16_t*)smem;
        _Pragma("unroll") for (int ni = 0; ni < 4; ++ni) {
          const int col = n0 + ni * 32 + r;
          if (col >= 4288 && col < 4304) {
            _Pragma("unroll") for (int mi = 0; mi < 2; ++mi) _Pragma("unroll") for (int reg = 0; reg < 16; ++reg)
              p.dt_raw[(size_t)(m0 + w * 64 + mi * 32 + crow(reg, h)) * 16 + (col - 4288)] = acc[mi][ni][reg];
          }
        }
        _Pragma("unroll") for (int half = 0; half < 2; ++half) {
          if ((w >> 1) == half) {
            _Pragma("unroll") for (int mi = 0; mi < 2; ++mi) _Pragma("unroll") for (int ni = 0; ni < 4; ++ni)
              _Pragma("unroll") for (int reg = 0; reg < 16; ++reg)
                sC[((w & 1) * 64 + mi * 32 + crow(reg, h)) * CS + ni * 32 + r] = f2bf(acc[mi][ni][reg]);
          }
          __syncthreads();
          drain_rows(sC, [&](int row, int col, u32x4 v) { route_store(p, (size_t)(m0 + 128 * half + row), n0 + col, v); });
          __syncthreads();
        }
      });
  }
  for (int sidx = local; sidx < 32; sidx += nl) {
    const int t = 256 + (sidx >> 1);
    const int m0 = (8 * xl + (t & 7)) * 256 + (sidx & 1) * 128, n0 = (t >> 3) * 128;
    gemm128(p.u, 1024, p.w_inT, 1024, 1024, m0, n0, smem,
      [&](const f32x16 (&acc)[2][2], int wm, int wn, int r, int h) {
        bf16_t* sC = (bf16_t*)smem;
        _Pragma("unroll") for (int ni = 0; ni < 2; ++ni) {
          int col = n0 + wn * 64 + ni * 32 + r;
          if (col >= 4288 && col < 4304) {
            _Pragma("unroll") for (int mi = 0; mi < 2; ++mi) _Pragma("unroll") for (int reg = 0; reg < 16; ++reg)
              p.dt_raw[(size_t)(m0 + wm * 64 + mi * 32 + crow(reg, h)) * 16 + (col - 4288)] = acc[mi][ni][reg];
          }
        }
        stage_vals(sC, acc, wm, wn, r, h);
        __syncthreads();
        drain_rows(sC, [&](int row, int col, u32x4 v) { route_store(p, (size_t)(m0 + row), n0 + col, v); });
      });
  }
}

DI void row_rnorm(const bf16_t* __restrict__ A, int lda, int K, int m0, float* rn) {
  const int tid = otid(), row = tid >> 1, half = tid & 1;
  const bf16_t* a = A + (size_t)(m0 + row) * lda + half * (K >> 1);
  float s = 0.f;
  for (int i = 0; i < (K >> 4); ++i) {
    u32x4 v = *(const u32x4*)(a + i * 8);
    float f;
    f = bflo(v.x); s += f * f; f = bfhi(v.x); s += f * f;
    f = bflo(v.y); s += f * f; f = bfhi(v.y); s += f * f;
    f = bflo(v.z); s += f * f; f = bfhi(v.z); s += f * f;
    f = bflo(v.w); s += f * f; f = bfhi(v.w); s += f * f;
  }
  s += __shfl_xor(s, 1);
  if (half == 0) rn[row] = rsqrtf(s / (float)K + 1e-6f);
}

DI void q_tile(const Params& p, int it, char* smem) {
  const int m0 = (it / 12) * 128, n0 = (it % 12) * 128;
  float* rn = (float*)(smem + 40960);
  gemm128<true>(p.lat, 704, p.w_qbT, 384, 384, m0, n0, smem,
    [&](const f32x16 (&acc)[2][2], int wm, int wn, int r, int h) {
      bf16_t* sC = (bf16_t*)smem;
      const int nbase = n0 + wn * 64;
      const bool rope = (nbase % 192) == 128;
      float2 csv[2][16];
      if (rope) {
        _Pragma("unroll") for (int mi = 0; mi < 2; ++mi) _Pragma("unroll") for (int reg = 0; reg < 16; ++reg)
          csv[mi][reg] = p.cs[(size_t)(m0 + wm * 64 + mi * 32 + crow(reg, h)) * 32 + r];
      }
      _Pragma("unroll") for (int mi = 0; mi < 2; ++mi) _Pragma("unroll") for (int reg = 0; reg < 16; ++reg) {
        const int rl = wm * 64 + mi * 32 + crow(reg, h);
        const float sc = rn[rl] * QSCALE;
        float v0 = acc[mi][0][reg] * sc, v1 = acc[mi][1][reg] * sc;
        if (rope) {
          float2 cs = csv[mi][reg];
          float o0 = v0 * cs.x - v1 * cs.y, o1 = v1 * cs.x + v0 * cs.y;
          v0 = o0; v1 = o1;
        }
        sC[rl * CS + wn * 64 + r] = f2bf(v0);
        sC[rl * CS + wn * 64 + 32 + r] = f2bf(v1);
      }
      __syncthreads();
      drain_rows(sC, [&](int row, int col, u32x4 v) {
        const int n = n0 + col, head = n / 192, d = n - head * 192;
        *(u32x4*)(p.Q + ((size_t)head * S + m0 + row) * 192 + d) = v;
      });
    }, rn);
}

DI void kv_tile(const Params& p, int it, char* smem) {
  const int m0 = (it >> 4) * 128, nt = it & 15, n0 = nt * 128;
  const int head = nt >> 1, kind = nt & 1;
  float* rn = (float*)(smem + 40960);
  gemm128<true>(p.lat + 384, 704, p.w_kvbT, 256, 256, m0, n0, smem,
    [&](const f32x16 (&acc)[2][2], int wm, int wn, int r, int h) {
      if (kind == 0) {
        bf16_t* sC = (bf16_t*)smem;
        _Pragma("unroll") for (int mi = 0; mi < 2; ++mi) _Pragma("unroll") for (int reg = 0; reg < 16; ++reg) {
          const int rl = wm * 64 + mi * 32 + crow(reg, h);
          const float sc = rn[rl];
          sC[rl * CS + wn * 64 + r] = f2bf(acc[mi][0][reg] * sc);
          sC[rl * CS + wn * 64 + 32 + r] = f2bf(acc[mi][1][reg] * sc);
        }
        __syncthreads();
        drain_rows(sC, [&](int row, int col, u32x4 v) {
          *(u32x4*)(p.Kk + ((size_t)head * S + m0 + row) * 192 + col) = v;
        });
      } else {
        _Pragma("unroll") for (int mi = 0; mi < 2; ++mi) _Pragma("unroll") for (int ni = 0; ni < 2; ++ni) {
          f32x16 t;
          _Pragma("unroll") for (int reg = 0; reg < 16; ++reg) t[reg] = acc[mi][ni][reg] * rn[wm * 64 + mi * 32 + crow(reg, h)];
          const int dv = wn * 64 + ni * 32 + r;
          bf16_t* d = p.VT + ((size_t)head * 128 + dv) * S + m0 + wm * 64 + mi * 32 + 8 * h;
          *(bf16x8*)(d) = pack8(t, 0);
          *(bf16x8*)(d + 16) = pack8(t, 1);
        }
      }
    }, rn);
}

DI void krope_item(const Params& p, int it) {
  const int tid = otid(), tok = it * 128 + (tid >> 1), half = tid & 1;
  const bf16_t* src = p.lat + (size_t)tok * 704 + 640 + half * 16;
  u32x4 a0 = *(const u32x4*)src, a1 = *(const u32x4*)(src + 8), b0 = *(const u32x4*)(src + 32), b1 = *(const u32x4*)(src + 40);
  unsigned xa[8] = {a0.x, a0.y, a0.z, a0.w, a1.x, a1.y, a1.z, a1.w};
  unsigned xb[8] = {b0.x, b0.y, b0.z, b0.w, b1.x, b1.y, b1.z, b1.w};
  unsigned o1[8], o2[8];
  _Pragma("unroll") for (int e = 0; e < 8; ++e) {
    float2 c0 = p.cs[(size_t)tok * 32 + half * 16 + 2 * e], c1 = p.cs[(size_t)tok * 32 + half * 16 + 2 * e + 1];
    float x1a = bflo(xa[e]), x1b = bfhi(xa[e]), x2a = bflo(xb[e]), x2b = bfhi(xb[e]);
    o1[e] = pk2(x1a * c0.x - x2a * c0.y, x1b * c1.x - x2b * c1.y);
    o2[e] = pk2(x2a * c0.x + x1a * c0.y, x2b * c1.x + x1b * c1.y);
  }
  _Pragma("unroll") for (int hd = 0; hd < 8; ++hd) {
    bf16_t* d = p.Kk + ((size_t)hd * S + tok) * 192 + 128 + half * 16;
    *(u32x4*)d = (u32x4){o1[0], o1[1], o1[2], o1[3]}; *(u32x4*)(d + 8) = (u32x4){o1[4], o1[5], o1[6], o1[7]};
    *(u32x4*)(d + 32) = (u32x4){o2[0], o2[1], o2[2], o2[3]}; *(u32x4*)(d + 40) = (u32x4){o2[4], o2[5], o2[6], o2[7]};
  }
}

template <int NT, class F>
DI void conv8(const Params& p, int tok0, int col, F&& f) {
  float w[4][8], bias[8];
  _Pragma("unroll") for (int i = 0; i < 4; ++i) {
    float4 a = *(const float4*)(p.conv_w + i * 1536 + col), b = *(const float4*)(p.conv_w + i * 1536 + col + 4);
    w[i][0] = a.x; w[i][1] = a.y; w[i][2] = a.z; w[i][3] = a.w; w[i][4] = b.x; w[i][5] = b.y; w[i][6] = b.z; w[i][7] = b.w;
  }
  { float4 a = *(const float4*)(p.conv_b + col), b = *(const float4*)(p.conv_b + col + 4);
    bias[0] = a.x; bias[1] = a.y; bias[2] = a.z; bias[3] = a.w; bias[4] = b.x; bias[5] = b.y; bias[6] = b.z; bias[7] = b.w; }
  float wf[4][8];
  _Pragma("unroll") for (int i = 0; i < 3; ++i) {
    int t = tok0 - 3 + i;
    u32x4 q4 = (t >= 0) ? *(const u32x4*)(p.xbc + (size_t)t * 1536 + col) : (u32x4){0, 0, 0, 0};
    wf[i][0] = bflo(q4.x); wf[i][1] = bfhi(q4.x); wf[i][2] = bflo(q4.y); wf[i][3] = bfhi(q4.y);
    wf[i][4] = bflo(q4.z); wf[i][5] = bfhi(q4.z); wf[i][6] = bflo(q4.w); wf[i][7] = bfhi(q4.w);
  }
  u32x4 nxt[NT];
  _Pragma("unroll") for (int j = 0; j < NT; ++j) nxt[j] = *(const u32x4*)(p.xbc + (size_t)(tok0 + j) * 1536 + col);
  _Pragma("unroll") for (int j = 0; j < NT; ++j) {
    const u32x4 q4 = nxt[j];
    wf[3][0] = bflo(q4.x); wf[3][1] = bfhi(q4.x); wf[3][2] = bflo(q4.y); wf[3][3] = bfhi(q4.y);
    wf[3][4] = bflo(q4.z); wf[3][5] = bfhi(q4.z); wf[3][6] = bflo(q4.w); wf[3][7] = bfhi(q4.w);
    float v[8];
    _Pragma("unroll") for (int e = 0; e < 8; ++e) {
      float acc = bias[e];
      _Pragma("unroll") for (int i = 0; i < 4; ++i) acc += w[i][e] * wf[i][e];
      v[e] = silu_f(acc);
    }
    f(j, v);
    _Pragma("unroll") for (int e = 0; e < 8; ++e) { wf[0][e] = wf[1][e]; wf[1][e] = wf[2][e]; wf[2][e] = wf[3][e]; }
  }
}

DI void ssd1_dtscan(const Params& p, int c, int head, int lane, float* fac) {
  const int t0 = c * 128;
  const float A = -__expf(p.a_log[head]), bias = p.dt_bias[head];
  float d0 = softplus_f(p.dt_raw[(size_t)(t0 + 2 * lane) * 16 + head] + bias);
  float d1 = softplus_f(p.dt_raw[(size_t)(t0 + 2 * lane + 1) * 16 + head] + bias);
  float s0 = d0 * A, s1 = s0 + d1 * A;
  float v = s1;
  _Pragma("unroll") for (int off = 1; off < 64; off <<= 1) { float n = __shfl_up(v, off); if (lane >= off) v += n; }
  const float excl = v - s1, aend = __shfl(v, 63);
  fac[2 * lane] = d0 * __expf(aend - (excl + s0));
  fac[2 * lane + 1] = d1 * __expf(aend - (excl + s1));
  if (lane == 0) p.cdecay[c * 16 + head] = __expf(aend);
}
DI void ssd1_item(const Params& p, int it, char* smem) {
  const int c = it >> 1, g = it & 1, t0 = c * 128;
  const int tid = otid(), lane = tid & 63, wave = __builtin_amdgcn_readfirstlane(tid >> 6), r = lane & 31, h = lane >> 5;
  float* fac = (float*)smem;
  bf16_t* BT = (bf16_t*)(smem + 1024);
  bf16_t* XT = BT + 128 * CS;
  __syncthreads();
  if (wave == 2) ssd1_dtscan(p, c, 8 * g, lane, fac);
  {
    const int cc = tid & 15, tg = tid >> 4, tl0 = tg * 8;
    unsigned pkd[8][4];
    conv8<8>(p, t0 + tl0, 1024 + 128 * g + 8 * cc, [&](int j, const float (&v)[8]) {
      _Pragma("unroll") for (int e = 0; e < 8; ++e) {
        unsigned b = f2bf(v[e]);
        if (j & 1) pkd[e][j >> 1] |= b << 16; else pkd[e][j >> 1] = b;
      }
    });
    _Pragma("unroll") for (int e = 0; e < 8; ++e)
      *(u32x4*)(BT + (8 * cc + e) * CS + tl0) = (u32x4){pkd[e][0], pkd[e][1], pkd[e][2], pkd[e][3]};
  }
  for (int hh = 0; hh < 8; ++hh) {
    const int head = 8 * g + hh;
    __syncthreads();
    if (wave < 2) {
      const int cc = tid & 7, tg = tid >> 3, tl0 = tg * 8;
      const float* fc = fac + (hh & 1) * 128 + tl0;
      unsigned pkd[8][4];
      conv8<8>(p, t0 + tl0, 64 * head + 8 * cc, [&](int j, const float (&v)[8]) {
        const float fsc = fc[j];
        _Pragma("unroll") for (int e = 0; e < 8; ++e) {
          unsigned b = f2bf(v[e] * fsc);
          if (j & 1) pkd[e][j >> 1] |= b << 16; else pkd[e][j >> 1] = b;
        }
      });
      _Pragma("unroll") for (int e = 0; e < 8; ++e)
        *(u32x4*)(XT + (8 * cc + e) * CS + tl0) = (u32x4){pkd[e][0], pkd[e][1], pkd[e][2], pkd[e][3]};
    } else if (wave == 2 && hh < 7) {
      ssd1_dtscan(p, c, head + 1, lane, fac + ((hh + 1) & 1) * 128);
    }
    __syncthreads();
    f32x16 acc[2] = {zero16(), zero16()};
    _Pragma("unroll") for (int kk = 0; kk < 8; ++kk) {
      bf16x8 b = *(const bf16x8*)(BT + (32 * wave + r) * CS + 16 * kk + 8 * h);
      bf16x8 a0 = *(const bf16x8*)(XT + r * CS + 16 * kk + 8 * h);
      bf16x8 a1 = *(const bf16x8*)(XT + (32 + r) * CS + 16 * kk + 8 * h);
      acc[0] = MFMA32(a0, b, acc[0]);
      acc[1] = MFMA32(a1, b, acc[1]);
    }
    bf16_t* st = p.states + (size_t)(c * 16 + head) * 8192;
    _Pragma("unroll") for (int pt = 0; pt < 2; ++pt) _Pragma("unroll") for (int reg = 0; reg < 16; ++reg)
      st[(32 * pt + crow(reg, h)) * 128 + 32 * wave + r] = f2bf(acc[pt][reg]);
  }
}

DI void phase2(const Params& p, char* smem) {
  constexpr int I_Q = 128 * 12, I_KV = 128 * 16, I_KR = 128, I_S1 = 256;
  int* sitem = (int*)(smem + SMEM_BYTES - 16);
  for (;;) {
    __syncthreads();
    if (threadIdx.x == 0) *sitem = atomicAdd(p.counters + 16, 1);
    __syncthreads();
    int it = *sitem;
    if (it >= I_Q + I_KV + I_KR + I_S1) break;
    if (it < I_S1) { ssd1_item(p, it, smem); continue; }
    it -= I_S1;
    if (it < I_Q) { q_tile(p, it, smem); continue; }
    it -= I_Q;
    if (it < I_KV) { kv_tile(p, it, smem); continue; }
    it -= I_KV;
    krope_item(p, it);
  }
}

DI void phase3(const Params& p) {
  const int gt = blockIdx.x * NTHREADS + threadIdx.x, nt = gridDim.x * NTHREADS;
  for (int e2 = gt; e2 < 65536; e2 += nt) {
    const int head = e2 >> 12;
    unsigned* base = (unsigned*)p.states + e2;
    float h0 = 0.f, h1 = 0.f;
    for (int c0 = 0; c0 < 128; c0 += 8) {
      unsigned v[8]; float dc[8];
      _Pragma("unroll") for (int j = 0; j < 8; ++j) { v[j] = base[(size_t)(c0 + j) * 65536]; dc[j] = p.cdecay[(c0 + j) * 16 + head]; }
      _Pragma("unroll") for (int j = 0; j < 8; ++j) {
        base[(size_t)(c0 + j) * 65536] = pk2(h0, h1);
        h0 = h0 * dc[j] + bflo(v[j]); h1 = h1 * dc[j] + bfhi(v[j]);
      }
    }
  }
}

constexpr int KS = 200;
constexpr int VS = 72;
DI void attn_item(const Params& p, int qb, int head, char* smem) {
  bf16_t* sK = (bf16_t*)smem;
  bf16_t* sV = sK + 64 * KS;
  const int tid = otid(), lane = tid & 63, wave = __builtin_amdgcn_readfirstlane(tid >> 6), r = lane & 31, h = lane >> 5;
  const int q0 = qb * 128, a = q0 + 32 * wave;
  const bf16_t* Kh = p.Kk + (size_t)head * S * 192;
  const bf16_t* Vh = p.VT + (size_t)head * 128 * S;
  bf16x8 qf[12];
  {
    const bf16_t* qp = p.Q + ((size_t)head * S + a + r) * 192 + 8 * h;
    _Pragma("unroll") for (int kk = 0; kk < 12; ++kk) qf[kk] = *(const bf16x8*)(qp + 16 * kk);
  }
  f32x16 o[4];
  _Pragma("unroll") for (int d = 0; d < 4; ++d) o[d] = zero16();
  float m = -INFINITY, l = 0.f;
  const int ntiles = 2 * qb + 2;
  u32x4 rk[6], rv[4];
  auto gload = [&](int kt) {
    _Pragma("unroll") for (int i = 0; i < 6; ++i) {
      int c = tid + 256 * i, row = c / 24, cc = c - row * 24;
      rk[i] = *(const u32x4*)(Kh + (size_t)(64 * kt + row) * 192 + cc * 8);
    }
    _Pragma("unroll") for (int i = 0; i < 4; ++i) {
      int c = tid + 256 * i, row = c >> 3, cc = c & 7;
      rv[i] = *(const u32x4*)(Vh + (size_t)row * S + 64 * kt + cc * 8);
    }
  };
  gload(0);
  for (int kt = 0; kt < ntiles; ++kt) {
    __syncthreads();
    _Pragma("unroll") for (int i = 0; i < 6; ++i) {
      int c = tid + 256 * i, row = c / 24, cc = c - row * 24;
      *(u32x4*)(sK + row * KS + cc * 8) = rk[i];
    }
    _Pragma("unroll") for (int i = 0; i < 4; ++i) {
      int c = tid + 256 * i, row = c >> 3, cc = c & 7;
      *(u32x4*)(sV + row * VS + cc * 8) = rv[i];
    }
    __syncthreads();
    gload(kt + 1 < ntiles ? kt + 1 : kt);
    asm volatile("" ::: "memory");
    if (64 * kt <= a + 31) {
      f32x16 s[2] = {zero16(), zero16()};
      _Pragma("unroll") for (int kk = 0; kk < 12; ++kk) {
        bf16x8 k0 = *(const bf16x8*)(sK + r * KS + 16 * kk + 8 * h);
        bf16x8 k1 = *(const bf16x8*)(sK + (32 + r) * KS + 16 * kk + 8 * h);
        s[0] = MFMA32(k0, qf[kk], s[0]);
        s[1] = MFMA32(k1, qf[kk], s[1]);
      }
      if (64 * kt + 63 > a) {
        const int qi = a + r;
        _Pragma("unroll") for (int t = 0; t < 2; ++t) _Pragma("unroll") for (int reg = 0; reg < 16; ++reg) {
          const int key = 64 * kt + 32 * t + crow(reg, h);
          if (key > qi) s[t][reg] = -INFINITY;
        }
      }
      float mx = s[0][0];
      _Pragma("unroll") for (int t = 0; t < 2; ++t) _Pragma("unroll") for (int reg = 0; reg < 16; ++reg) mx = fmaxf(mx, s[t][reg]);
      mx = xhalf_max(mx);
      const float mn = fmaxf(m, mx);
      const float alpha = __builtin_amdgcn_exp2f(m - mn);
      m = mn;
      float ps = 0.f;
      _Pragma("unroll") for (int t = 0; t < 2; ++t) _Pragma("unroll") for (int reg = 0; reg < 16; ++reg) {
        float e = __builtin_amdgcn_exp2f(s[t][reg] - mn);
        s[t][reg] = e; ps += e;
      }
      l = l * alpha + ps;
      _Pragma("unroll") for (int d = 0; d < 4; ++d) _Pragma("unroll") for (int reg = 0; reg < 16; ++reg) o[d][reg] *= alpha;
      bf16x8 pf[4];
      pf[0] = pack8(s[0], 0); pf[1] = pack8(s[0], 1); pf[2] = pack8(s[1], 0); pf[3] = pack8(s[1], 1);
      _Pragma("unroll") for (int ks = 0; ks < 4; ++ks) _Pragma("unroll") for (int d = 0; d < 4; ++d) {
        bf16x8 vf = *(const bf16x8*)(sV + (32 * d + r) * VS + 16 * ks + 8 * h);
        o[d] = MFMA32(vf, pf[ks], o[d]);
      }
    }
  }
  l += __shfl_xor(l, 32);
  const float inv = 1.f / l;
  bf16_t* mrow = p.mix + (size_t)(a + r) * 2048 + head * 128 + 4 * h;
  u32x2 zva[4][4];
  _Pragma("unroll") for (int d = 0; d < 4; ++d) _Pragma("unroll") for (int g4 = 0; g4 < 4; ++g4) zva[d][g4] = *(const u32x2*)(mrow + 32 * d + 8 * g4);
  _Pragma("unroll") for (int d = 0; d < 4; ++d) {
   _Pragma("unroll") for (int g4 = 0; g4 < 4; ++g4) {
    bf16_t* zp = mrow + 32 * d + 8 * g4;
    u32x2 z = zva[d][g4];
    float z0 = bflo(z.x), z1 = bfhi(z.x), z2 = bflo(z.y), z3 = bfhi(z.y);
    u32x2 w;
    w.x = pk2(o[d][4 * g4 + 0] * inv * silu_f(z0), o[d][4 * g4 + 1] * inv * silu_f(z1));
    w.y = pk2(o[d][4 * g4 + 2] * inv * silu_f(z2), o[d][4 * g4 + 3] * inv * silu_f(z3));
    *(u32x2*)zp = w;
   }
  }
}

DI void ssd2_item(const Params& p, int it, char* smem) {
  const int c = it >> 1, g = it & 1, t0 = c * 128;
  const int tid = otid(), lane = tid & 63, wave = __builtin_amdgcn_readfirstlane(tid >> 6), r = lane & 31, h = lane >> 5;
  float* acum = (float*)smem;
  float* dtv = acum + 1024;
  bf16_t* Cf = (bf16_t*)(smem + 8192);
  bf16_t* R = Cf + 128 * CS;
  bf16_t* Bs = R;
  bf16_t* XT = R;
  __syncthreads();
  {
    const int hh = tid >> 5, l32 = tid & 31, head = 8 * g + hh;
    const float A = -__expf(p.a_log[head]), bias = p.dt_bias[head];
    float d[4], cs[4];
    _Pragma("unroll") for (int j = 0; j < 4; ++j) d[j] = softplus_f(p.dt_raw[(size_t)(t0 + 4 * l32 + j) * 16 + head] + bias);
    cs[0] = d[0] * A; cs[1] = cs[0] + d[1] * A; cs[2] = cs[1] + d[2] * A; cs[3] = cs[2] + d[3] * A;
    float v = cs[3];
    _Pragma("unroll") for (int off = 1; off < 32; off <<= 1) { float n = __shfl_up(v, off, 32); if (l32 >= off) v += n; }
    const float excl = v - cs[3];
    _Pragma("unroll") for (int j = 0; j < 4; ++j) { acum[hh * 128 + 4 * l32 + j] = excl + cs[j]; dtv[hh * 128 + 4 * l32 + j] = d[j]; }
  }
  if (tid < 128) {
    const int cc = tid & 15, tg = tid >> 4;
    _Pragma("unroll 1") for (int half = 0; half < 2; ++half)
      conv8<8>(p, t0 + tg * 16 + half * 8, 1280 + 128 * g + 8 * cc, [&](int j, const float (&v)[8]) {
        *(u32x4*)(Cf + (tg * 16 + half * 8 + j) * CS + 8 * cc) = (u32x4){pk2(v[0], v[1]), pk2(v[2], v[3]), pk2(v[4], v[5]), pk2(v[6], v[7])};
      });
  }
  f32x16 cbT[4];
  _Pragma("unroll") for (int st = 0; st < 4; ++st) cbT[st] = zero16();
  _Pragma("unroll 1") for (int nh = 0; nh < 2; ++nh) {
    __syncthreads();
    if (tid >= 128) {
      const int t2 = tid - 128, cc = t2 & 7, tg = t2 >> 3;
      conv8<8>(p, t0 + tg * 8, 1024 + 128 * g + 64 * nh + 8 * cc, [&](int j, const float (&v)[8]) {
        *(u32x4*)(Bs + (tg * 8 + j) * 72 + 8 * cc) = (u32x4){pk2(v[0], v[1]), pk2(v[2], v[3]), pk2(v[4], v[5]), pk2(v[6], v[7])};
      });
    }
    __syncthreads();
    _Pragma("unroll") for (int kk = 0; kk < 4; ++kk) {
      bf16x8 cfr = *(const bf16x8*)(Cf + (32 * wave + r) * CS + 64 * nh + 16 * kk + 8 * h);
      _Pragma("unroll") for (int st = 0; st < 4; ++st) {
        if (st <= wave) {
          bf16x8 bfr = *(const bf16x8*)(Bs + (32 * st + r) * 72 + 16 * kk + 8 * h);
          cbT[st] = MFMA32(bfr, cfr, cbT[st]);
        }
      }
    }
  }
  const int ll = 32 * wave + r;
  float sumsq = 0.f;
  bf16_t* mrow = p.mix + (size_t)(t0 + ll) * 2048 + 1024 + 512 * g + 4 * h;
  for (int hh = 0; hh < 8; ++hh) {
    const int head = 8 * g + hh;
    u32x2 zv[2][4];
    {
      _Pragma("unroll") for (int pt = 0; pt < 2; ++pt) _Pragma("unroll") for (int g4 = 0; g4 < 4; ++g4) zv[pt][g4] = *(const u32x2*)(mrow + 64 * hh + 32 * pt + 8 * g4);
      asm volatile("" ::: "memory");
    }
    __syncthreads();
    {
      const int cc = tid & 7, tg = tid >> 3;
      const int col = 64 * head + 8 * cc, tl0 = tg * 4;
      unsigned pkd[8][2];
      float vprev[8];
      conv8<4>(p, t0 + tl0, col, [&](int j, const float (&v)[8]) {
        const float fsc = dtv[hh * 128 + tl0 + j];
        _Pragma("unroll") for (int e = 0; e < 8; ++e) {
          if (j & 1) pkd[e][j >> 1] = pk2(vprev[e], v[e] * fsc); else vprev[e] = v[e] * fsc;
        }
      });
      _Pragma("unroll") for (int e = 0; e < 8; ++e) *(u32x2*)(XT + (8 * cc + e) * 140 + tl0) = (u32x2){pkd[e][0], pkd[e][1]};
    }
    __syncthreads();
    const float a_l = acum[hh * 128 + ll], dskip = p.d_skip[head] / dtv[hh * 128 + ll];
    int aoff = hh * 128 + 4 * h, dlt = 4 * h - r;
    asm volatile("" : "+v"(aoff), "+v"(dlt));
    f32x16 yT[2] = {zero16(), zero16()};
    {
      const bf16_t* pv = p.states + (size_t)(c * 16 + head) * 8192 + (size_t)r * 128 + 8 * h;
      bf16x8 pvr[2][8];
      _Pragma("unroll") for (int kk = 0; kk < 8; ++kk) { pvr[0][kk] = *(const bf16x8*)(pv + 16 * kk); pvr[1][kk] = *(const bf16x8*)(pv + 32 * 128 + 16 * kk); }
      _Pragma("unroll") for (int kk = 0; kk < 8; ++kk) {
        bf16x8 cfr = *(const bf16x8*)(Cf + (32 * wave + r) * CS + 16 * kk + 8 * h);
        yT[0] = MFMA32(pvr[0][kk], cfr, yT[0]);
        yT[1] = MFMA32(pvr[1][kk], cfr, yT[1]);
      }
      const float ea = __expf(a_l);
      _Pragma("unroll") for (int reg = 0; reg < 16; ++reg) { yT[0][reg] *= ea; yT[1][reg] *= ea; }
    }
    _Pragma("unroll") for (int st = 0; st < 4; ++st) {
      if (st <= wave) {
        f32x16 mt;
        _Pragma("unroll") for (int reg = 0; reg < 16; ++reg) {
          const int creg = 32 * st + (reg & 3) + 8 * (reg >> 2);
          float v = cbT[st][reg] * __expf(fminf(a_l - acum[aoff + creg], 0.f));
          if (st == wave) {
            const int dd = (reg & 3) + 8 * (reg >> 2) + dlt;
            if (dd > 0) v = 0.f;
            if (dd == 0) v += dskip;
          }
          mt[reg] = v;
        }
        _Pragma("unroll") for (int ks = 0; ks < 2; ++ks) {
          bf16x8 pf = pack8(mt, ks);
          _Pragma("unroll") for (int pt = 0; pt < 2; ++pt) {
            const bf16_t* xp = XT + (32 * pt + r) * 140 + 32 * st + 16 * ks + 4 * h;
            bf16x4 lo = *(const bf16x4*)xp, hi = *(const bf16x4*)(xp + 8);
            bf16x8 xa = __builtin_shufflevector(lo, hi, 0, 1, 2, 3, 4, 5, 6, 7);
            yT[pt] = MFMA32(xa, pf, yT[pt]);
          }
        }
      }
    }
    _Pragma("unroll") for (int pt = 0; pt < 2; ++pt) _Pragma("unroll") for (int g4 = 0; g4 < 4; ++g4) {
      bf16_t* zp = mrow + 64 * hh + 32 * pt + 8 * g4;
      u32x2 z = zv[pt][g4];
      float zz[4] = {bflo(z.x), bfhi(z.x), bflo(z.y), bfhi(z.y)};
      float hf[4];
      _Pragma("unroll") for (int j = 0; j < 4; ++j) {
        float y = yT[pt][4 * g4 + j];
        hf[j] = y * silu_f(zz[j]);
        sumsq += hf[j] * hf[j];
      }
      u32x2 w; w.x = pk2(hf[0], hf[1]); w.y = pk2(hf[2], hf[3]);
      *(u32x2*)zp = w;
    }
  }
  sumsq += __shfl_xor(sumsq, 32);
  const float rnm = rsqrtf(sumsq * (1.f / 512.f) + 1e-6f);
  const float* gp = p.ssm_g + 512 * g + 4 * h;
  _Pragma("unroll 1") for (int i0 = 0; i0 < 64; i0 += 16) {
    u32x2 zz[16];
    _Pragma("unroll") for (int j = 0; j < 16; ++j) {
      const int i = i0 + j, off = 64 * (i >> 3) + 32 * ((i >> 2) & 1) + 8 * (i & 3);
      zz[j] = *(const u32x2*)(mrow + off);
    }
    _Pragma("unroll") for (int j = 0; j < 16; ++j) {
      const int i = i0 + j, off = 64 * (i >> 3) + 32 * ((i >> 2) & 1) + 8 * (i & 3);
      float4 gg = *(const float4*)(gp + off);
      u32x2 w;
      w.x = pk2(bflo(zz[j].x) * rnm * gg.x, bfhi(zz[j].x) * rnm * gg.y);
      w.y = pk2(bflo(zz[j].y) * rnm * gg.z, bfhi(zz[j].y) * rnm * gg.w);
      *(u32x2*)(mrow + off) = w;
    }
  }
}

DI void phase4(const Params& p, char* smem) {
  int* sitem = (int*)(smem + SMEM_BYTES - 16);
  for (;;) {
    __syncthreads();
    if (threadIdx.x == 0) *sitem = atomicAdd(p.counters, 1);
    __syncthreads();
    const int it = *sitem;
    if (it >= 256 + 1024) break;
    if (it < 256) ssd2_item(p, it, smem);
    else { const int i = it - 256; attn_item(p, 127 - (i >> 3), i & 7, smem); }
  }
}

DI void phase5(const Params& p, char* smem) {
  const int xl = blockIdx.x & 7, local = blockIdx.x >> 3, nl = gridDim.x >> 3;
  for (int t = local; t < 64; t += nl) {
    const int m0 = (8 * xl + (t >> 3)) * 256, n0 = (t & 7) * 128;
    gemm256(p.mix, 2048, p.w_outT, 2048, 2048, m0, n0, smem,
      [&](const f32x16 (&acc)[2][4], int w, int r, int h) {
        _Pragma("unroll") for (int ni = 0; ni < 4; ++ni) {
          const int col = n0 + ni * 32 + r;
          const float gate = p.mod[2048 + col];
          const float* xb = p.x + (size_t)(m0 + w * 64) * 1024;
          float* ob = p.out + (size_t)(m0 + w * 64) * 1024;
          const int loff = 4 * h * 1024 + col;
          _Pragma("unroll") for (int mi = 0; mi < 2; ++mi) {
            float xv[16];
            _Pragma("unroll") for (int reg = 0; reg < 16; ++reg) xv[reg] = xb[(mi * 32 + (reg & 3) + 8 * (reg >> 2)) * 1024 + loff];
            _Pragma("unroll") for (int reg = 0; reg < 16; ++reg)
              ob[(mi * 32 + (reg & 3) + 8 * (reg >> 2)) * 1024 + loff] = DN_ALPHA * xv[reg] + gate * acc[mi][ni][reg];
          }
        }
      });
  }
}

DI void phase6(const Params& p) {
  const int t6 = otid(), lane = t6 & 63, wv = blockIdx.x * 4 + (t6 >> 6), nw = gridDim.x * 4;
  float4 g[4], bb[4];
  _Pragma("unroll") for (int i = 0; i < 4; ++i) { g[i] = ((const float4*)p.ln_g)[lane + 64 * i]; bb[i] = ((const float4*)p.ln_b)[lane + 64 * i]; }
  for (int row0 = 2 * wv; row0 < S; row0 += 2 * nw) {
    float4 v[2][4];
    _Pragma("unroll") for (int j = 0; j < 2; ++j) _Pragma("unroll") for (int i = 0; i < 4; ++i)
      v[j][i] = ((const float4*)(p.out + (size_t)(row0 + j) * 1024))[lane + 64 * i];
    _Pragma("unroll") for (int j = 0; j < 2; ++j) {
      float s = 0.f;
      _Pragma("unroll") for (int i = 0; i < 4; ++i) s += v[j][i].x + v[j][i].y + v[j][i].z + v[j][i].w;
      _Pragma("unroll") for (int o = 32; o > 0; o >>= 1) s += __shfl_xor(s, o);
      const float mu = s * (1.f / 1024.f);
      float q = 0.f;
      _Pragma("unroll") for (int i = 0; i < 4; ++i) {
        float a = v[j][i].x - mu, b = v[j][i].y - mu, c2 = v[j][i].z - mu, d = v[j][i].w - mu;
        q += a * a + b * b + c2 * c2 + d * d;
      }
      _Pragma("unroll") for (int o = 32; o > 0; o >>= 1) q += __shfl_xor(q, o);
      const float rs = rsqrtf(q * (1.f / 1024.f) + 1e-5f);
      float4* rp = (float4*)(p.out + (size_t)(row0 + j) * 1024);
      _Pragma("unroll") for (int i = 0; i < 4; ++i) {
        float4 o4;
        o4.x = (v[j][i].x - mu) * rs * g[i].x + bb[i].x; o4.y = (v[j][i].y - mu) * rs * g[i].y + bb[i].y;
        o4.z = (v[j][i].z - mu) * rs * g[i].z + bb[i].z; o4.w = (v[j][i].w - mu) * rs * g[i].w + bb[i].w;
        rp[lane + 64 * i] = o4;
      }
    }
  }
}

#if MULTI
template <int PH>
__global__ void __launch_bounds__(NTHREADS, 2) phase_kernel(Params p) {
  __shared__ __attribute__((aligned(16))) char smem[SMEM_BYTES];
  if (PH == 0) phase0(p, smem);
  if (PH == 1) phase0b(p, smem);
  if (PH == 2) phase1(p, smem);
  if (PH == 3) phase2(p, smem);
  if (PH == 4) phase3(p);
  if (PH == 5) phase4(p, smem);
  if (PH == 6) phase5(p, smem);
  if (PH == 7) phase6(p);
}
#else
__global__ void __launch_bounds__(NTHREADS, 2) mega_kernel(Params p) {
  __shared__ __attribute__((aligned(16))) char smem[SMEM_BYTES];
  cg::grid_group grid = cg::this_grid();
  volatile LAS unsigned* st = (volatile LAS unsigned*)(smem + SMEM_BYTES - 64);
  if (threadIdx.x == 0) { st[0] = 0u; st[1] = 0u; }
  __syncthreads();
  XcdBarrier xb = xcd_barrier_post(p.bar, st);
  if (p.probe == 0x7fffffff) grid.sync();
  phase0(p, smem);  xcd_barrier(xb);
  phase0b(p, smem); xcd_barrier(xb);
  phase1(p, smem);  xcd_barrier(xb);
  phase2(p, smem);  xcd_barrier(xb);
  phase3(p);        xcd_barrier(xb);
  phase4(p, smem);  xcd_barrier(xb);
  phase5(p, smem);  xcd_barrier(xb);
  phase6(p);
}
#endif

extern "C" void kernel_launch(void* const* d_in, const int* in_sizes, int n_in, void* d_out, int out_size, void* d_ws,
                              size_t ws_size, hipStream_t stream) {
  Params p{};
  p.x = (const float*)d_in[0]; p.c = (const float*)d_in[1]; p.pos = (const int*)d_in[2];
  p.w_ada = (const float*)d_in[3]; p.b_ada = (const float*)d_in[4]; p.w_in = (const float*)d_in[5];
  p.q_g = (const float*)d_in[6]; p.w_qb = (const float*)d_in[7]; p.kv_g = (const float*)d_in[8]; p.w_kvb = (const float*)d_in[9];
  p.conv_w = (const float*)d_in[10]; p.conv_b = (const float*)d_in[11]; p.dt_bias = (const float*)d_in[12];
  p.a_log = (const float*)d_in[13]; p.d_skip = (const float*)d_in[14]; p.ssm_g = (const float*)d_in[15];
  p.w_out = (const float*)d_in[16]; p.ln_g = (const float*)d_in[17]; p.ln_b = (const float*)d_in[18];
  p.out = (float*)d_out;
  char* ws = (char*)d_ws;
  const size_t MB = 1048576;
  p.Q = (bf16_t*)(ws + 0 * MB); p.u = (bf16_t*)(ws + 0 * MB);
  p.Kk = (bf16_t*)(ws + 48 * MB);
  p.lat = (bf16_t*)(ws + 96 * MB);
  p.xbc = (bf16_t*)(ws + 118 * MB);
  p.mix = (bf16_t*)(ws + 166 * MB);
  p.w_inT = (bf16_t*)(ws + 230 * MB);
  p.w_qbT = (bf16_t*)(ws + 239 * MB);
  p.w_kvbT = (bf16_t*)(ws + 241 * MB);
  p.w_outT = (bf16_t*)(ws + 243 * MB);
  p.dt_raw = (float*)(ws + 247 * MB);
  p.cs = (float2*)(ws + 248 * MB);
  p.modp = (float*)(ws + 252 * MB);
  p.mod = (float*)(ws + 252 * MB + 262144);
  p.cdecay = (float*)(ws + 252 * MB + 327680);
  p.counters = (int*)(ws + 252 * MB + 393216);
  p.bar = (unsigned*)(ws + 253 * MB);
  p.states = (bf16_t*)d_out;
  p.VT = (bf16_t*)((char*)d_out + 32 * MB);
  for (int i = 0; i < 32; ++i) p.inv_freq[i] = 1.0f / powf(10000.0f, (float)i / 32.0f);
#if MULTI
  const int G = 512;
  phase_kernel<0><<<G, NTHREADS, 0, stream>>>(p);
  phase_kernel<1><<<G, NTHREADS, 0, stream>>>(p);
  phase_kernel<2><<<G, NTHREADS, 0, stream>>>(p);
  phase_kernel<3><<<G, NTHREADS, 0, stream>>>(p);
  phase_kernel<4><<<G, NTHREADS, 0, stream>>>(p);
  phase_kernel<5><<<G, NTHREADS, 0, stream>>>(p);
  phase_kernel<6><<<G, NTHREADS, 0, stream>>>(p);
  phase_kernel<7><<<G, NTHREADS, 0, stream>>>(p);
#else
  static int grid_blocks = 0;
  if (!grid_blocks) {
    int dev = 0, cus = 0, per_cu = 0;
    hipGetDevice(&dev);
    hipDeviceGetAttribute(&cus, hipDeviceAttributeMultiprocessorCount, dev);
    hipOccupancyMaxActiveBlocksPerMultiprocessor(&per_cu, mega_kernel, NTHREADS, 0);
    if (per_cu > 2) per_cu = 2;
    grid_blocks = cus * per_cu;
  }
  hipMemsetAsync(p.bar, 0, XCD_BAR_WORDS * 4, stream);
  void* args[] = {&p};
  hipError_t e = hipLaunchCooperativeKernel((void*)mega_kernel, dim3(grid_blocks), dim3(NTHREADS), args, 0, stream);
  if (e != hipSuccess) fprintf(stderr, "cooperative launch failed: %s (grid %d)\n", hipGetErrorString(e), grid_blocks);
#endif
}
```

```cpp
#include <hip/hip_runtime.h>
#include <hip/hip_cooperative_groups.h>
#include <cstdio>
#include <cmath>
namespace cg = cooperative_groups;

#ifndef MULTI
#define MULTI 0
#endif

typedef unsigned short bf16_t;
typedef __attribute__((ext_vector_type(8))) short bf16x8;
typedef __attribute__((ext_vector_type(4))) short bf16x4;
typedef __attribute__((ext_vector_type(16))) float f32x16;
typedef __attribute__((ext_vector_type(2))) __bf16 bf2_t;
typedef __attribute__((ext_vector_type(2))) float f2_t;
typedef __attribute__((ext_vector_type(4))) unsigned u32x4;
typedef __attribute__((ext_vector_type(2))) unsigned u32x2;
#define DI __device__ __forceinline__
#define MFMA32(a, b, c) __builtin_amdgcn_mfma_f32_32x32x16_bf16((a), (b), (c), 0, 0, 0)

constexpr int S = 16384;
constexpr int NTHREADS = 256;
constexpr int SMEM_BYTES = 61504;
constexpr float QSCALE = 0.07216878364870322f * 1.4426950408889634f;
constexpr float DN_ALPHA = 1.189207115002721f;

struct Params {
  const float *x, *c; const int* pos;
  const float *w_ada, *b_ada, *w_in, *q_g, *w_qb, *kv_g, *w_kvb, *conv_w, *conv_b, *dt_bias, *a_log, *d_skip, *ssm_g, *w_out, *ln_g, *ln_b;
  float* out;
  bf16_t *u, *lat, *xbc, *mix, *Q, *Kk, *VT, *states, *w_inT, *w_qbT, *w_kvbT, *w_outT;
  float *dt_raw, *modp, *mod, *cdecay;
  float2* cs;
  int* counters;
  unsigned* bar;
  int probe; int pad0;
  float inv_freq[32];
};

DI unsigned pk2(float a, float b) { f2_t v = {a, b}; bf2_t r = __builtin_convertvector(v, bf2_t); return __builtin_bit_cast(unsigned, r); }
DI bf16_t f2bf(float a) { return (bf16_t)(pk2(a, 0.f) & 0xffffu); }
DI float bf2f(unsigned h) { return __uint_as_float(h << 16); }
DI float bflo(unsigned w) { return __uint_as_float(w << 16); }
DI float bfhi(unsigned w) { return __uint_as_float(w & 0xffff0000u); }
DI int crow(int reg, int h) { return (reg & 3) + 8 * (reg >> 2) + 4 * h; }
DI float silu_f(float x) { return x * __builtin_amdgcn_rcpf(1.f + __expf(-x)); }
DI float softplus_f(float x) { return fmaxf(x, 0.f) + log1pf(__expf(-fabsf(x))); }
DI bf16x8 pack8(const f32x16& x, int s) {
  u32x4 p;
  p.x = pk2(x[8 * s + 0], x[8 * s + 1]); p.y = pk2(x[8 * s + 2], x[8 * s + 3]);
  p.z = pk2(x[8 * s + 4], x[8 * s + 5]); p.w = pk2(x[8 * s + 6], x[8 * s + 7]);
  return __builtin_bit_cast(bf16x8, p);
}
DI int otid() { int t = threadIdx.x; asm volatile("" : "+v"(t)); return t; }
DI float xhalf_max(float v) {
  auto r = __builtin_amdgcn_permlane32_swap(__float_as_uint(v), __float_as_uint(v), false, false);
  return fmaxf(__uint_as_float(r[0]), __uint_as_float(r[1]));
}
DI f32x16 zero16() { f32x16 z; _Pragma("unroll") for (int i = 0; i < 16; ++i) z[i] = 0.f; return z; }


#define XB_TMO      128
#define XB_XCNT(j)  (256  + 64 * (j))
#define XB_XSUB(j)  (1280 + 64 * (j))
#define XB_XGEN(j)  (2304 + 64 * (j))
#define XB_TOP      3328
#define XB_TOPGEN   3392
#define XCD_BAR_WORDS 3456
#define XB_SPIN_CAP (1u << 22)
#define LAS __attribute__((address_space(3)))
DI unsigned xb_ld(unsigned* p)              { return __hip_atomic_load(p, __ATOMIC_RELAXED, __HIP_MEMORY_SCOPE_AGENT); }
DI unsigned xb_add(unsigned* p, unsigned v) { return __hip_atomic_fetch_add(p, v, __ATOMIC_RELAXED, __HIP_MEMORY_SCOPE_AGENT); }
DI unsigned xb_xcc_id() { return (unsigned)__builtin_amdgcn_s_getreg((3 << 11) | 20) & 0xFu; }
#define XB_SPIN(cond, bar) do { unsigned _sp = 0; while (cond) { __builtin_amdgcn_s_sleep(1); \
    if ((++_sp & 255u) == 0u) { if (xb_ld(&(bar)[XB_TMO])) break; if (_sp > XB_SPIN_CAP) { atomicAdd(&(bar)[XB_TMO], 1u); break; } } } } while (0)
struct XcdBarrier { unsigned* bar; unsigned x; volatile LAS unsigned* st; };
DI XcdBarrier xcd_barrier_post(unsigned* bar, volatile LAS unsigned* st) {
  XcdBarrier b; b.bar = bar; b.x = xb_xcc_id(); b.st = st;
  if (threadIdx.x == 0) (void)xb_add(&bar[XB_XCNT(b.x)], 1u);
  return b;
}
DI void xcd_barrier_complete(unsigned* bar, unsigned x, unsigned& nloc, unsigned& nx) {
  const unsigned G = gridDim.x * gridDim.y * gridDim.z;
  unsigned sum, cnt, mine, sp = 0u;
  for (;;) {
    sum = 0u; cnt = 0u; mine = 0u;
    _Pragma("unroll") for (unsigned j = 0; j < 16; ++j) { const unsigned c = xb_ld(&bar[XB_XCNT(j)]); sum += c; cnt += (c > 0u) ? 1u : 0u; mine = (j == x) ? c : mine; }
    if (sum == G) break;
    __builtin_amdgcn_s_sleep(1);
    if ((++sp & 255u) == 0u) { if (xb_ld(&bar[XB_TMO])) break; if (sp > XB_SPIN_CAP) { atomicAdd(&bar[XB_TMO], 1u); break; } }
  }
  nloc = mine > 0u ? mine : 1u; nx = cnt > 0u ? cnt : 1u;
}
DI void xcd_barrier(const XcdBarrier& b) {
  asm volatile("s_waitcnt vmcnt(0)" ::: "memory");
  __syncthreads();
  if (threadIdx.x == 0) {
    unsigned* bar = b.bar;
    __builtin_amdgcn_s_waitcnt(0);
    unsigned nloc = b.st[0], nx = b.st[1];
    if (nloc == 0u) { xcd_barrier_complete(bar, b.x, nloc, nx); b.st[0] = nloc; b.st[1] = nx; }
    const unsigned old = xb_add(&bar[XB_XSUB(b.x)], 1u);
    const unsigned gen = old / nloc;
    if (old + 1u == (gen + 1u) * nloc) {
      __builtin_amdgcn_fence(__ATOMIC_RELEASE, "agent");
      asm volatile("s_waitcnt vmcnt(0)" ::: "memory");
      const unsigned og = xb_add(&bar[XB_TOP], 1u);
      const unsigned tg = og / nx;
      if (og + 1u == (tg + 1u) * nx) xb_add(&bar[XB_TOPGEN], 1u);
      else XB_SPIN(xb_ld(&bar[XB_TOPGEN]) == tg, bar);
      __builtin_amdgcn_fence(__ATOMIC_ACQUIRE, "agent");
      xb_add(&bar[XB_XGEN(b.x)], 1u);
      asm volatile("s_waitcnt vmcnt(0)" ::: "memory");
    } else {
      XB_SPIN(xb_ld(&bar[XB_XGEN(b.x)]) == gen, bar);
      __builtin_amdgcn_fence(__ATOMIC_ACQUIRE, "agent");
      asm volatile("s_waitcnt vmcnt(0)" ::: "memory");
    }
  }
  __syncthreads();
}

constexpr int GS = 72;
DI float sumsq8(u32x4 v) {
  float s = 0.f, f;
  f = bflo(v.x); s += f * f; f = bfhi(v.x); s += f * f;
  f = bflo(v.y); s += f * f; f = bfhi(v.y); s += f * f;
  f = bflo(v.z); s += f * f; f = bfhi(v.z); s += f * f;
  f = bflo(v.w); s += f * f; f = bfhi(v.w); s += f * f;
  return s;
}
template <bool SS = false, class Epi>
DI void gemm128(const bf16_t* __restrict__ A, int lda, const bf16_t* __restrict__ Bt, int ldb, int K, int m0, int n0,
                char* smem, Epi&& epi, float* rn = nullptr) {
  bf16_t* sA = (bf16_t*)smem;
  bf16_t* sB = sA + 128 * GS;
  const int tid = otid(), lane = tid & 63, wave = __builtin_amdgcn_readfirstlane(tid >> 6);
  const int r = lane & 31, h = lane >> 5;
  const int wm = wave >> 1, wn = wave & 1;
  f32x16 acc[2][2];
  _Pragma("unroll") for (int i = 0; i < 2; ++i) _Pragma("unroll") for (int j = 0; j < 2; ++j) acc[i][j] = zero16();
  const int lrow = tid >> 3, lcc = tid & 7;
  const bf16_t* Ag = A + (size_t)(m0 + lrow) * lda + lcc * 8;
  const bf16_t* Bg = Bt + (size_t)(n0 + lrow) * ldb + lcc * 8;
  u32x4 ra[4], rb[4];
  _Pragma("unroll") for (int i = 0; i < 4; ++i) {
    ra[i] = *(const u32x4*)(Ag + (size_t)(32 * i) * lda);
    rb[i] = *(const u32x4*)(Bg + (size_t)(32 * i) * ldb);
  }
  const int nk = K >> 6;
  float ssq[4] = {0.f, 0.f, 0.f, 0.f};
  for (int kt = 0; kt < nk; ++kt) {
    __syncthreads();
    _Pragma("unroll") for (int i = 0; i < 4; ++i) {
      *(u32x4*)(sA + (lrow + 32 * i) * GS + lcc * 8) = ra[i];
      *(u32x4*)(sB + (lrow + 32 * i) * GS + lcc * 8) = rb[i];
      if (SS) ssq[i] += sumsq8(ra[i]);
    }
    __syncthreads();
    if (kt + 1 < nk) {
      _Pragma("unroll") for (int i = 0; i < 4; ++i) {
        ra[i] = *(const u32x4*)(Ag + (size_t)(32 * i) * lda + (kt + 1) * 64);
        rb[i] = *(const u32x4*)(Bg + (size_t)(32 * i) * ldb + (kt + 1) * 64);
      }
    }
    _Pragma("unroll") for (int kk = 0; kk < 4; ++kk) {
      bf16x8 a0 = *(const bf16x8*)(sA + (wm * 64 + r) * GS + kk * 16 + h * 8);
      bf16x8 a1 = *(const bf16x8*)(sA + (wm * 64 + 32 + r) * GS + kk * 16 + h * 8);
      bf16x8 b0 = *(const bf16x8*)(sB + (wn * 64 + r) * GS + kk * 16 + h * 8);
      bf16x8 b1 = *(const bf16x8*)(sB + (wn * 64 + 32 + r) * GS + kk * 16 + h * 8);
      acc[0][0] = MFMA32(a0, b0, acc[0][0]);
      acc[0][1] = MFMA32(a0, b1, acc[0][1]);
      acc[1][0] = MFMA32(a1, b0, acc[1][0]);
      acc[1][1] = MFMA32(a1, b1, acc[1][1]);
    }
  }
  if (SS) {
    _Pragma("unroll") for (int i = 0; i < 4; ++i) {
      float v = ssq[i];
      v += __shfl_xor(v, 1); v += __shfl_xor(v, 2); v += __shfl_xor(v, 4);
      if (lcc == 0) rn[lrow + 32 * i] = rsqrtf(v / (float)K + 1e-6f);
    }
  }
  __syncthreads();
  epi(acc, wm, wn, r, h);
}

template <class Epi>
DI void gemm256(const bf16_t* __restrict__ A, int lda, const bf16_t* __restrict__ Bt, int ldb, int K, int m0, int n0,
                char* smem, Epi&& epi) {
  bf16_t* sA = (bf16_t*)smem;
  bf16_t* sB = sA + 256 * GS;
  const int tid = otid(), lane = tid & 63, wave = __builtin_amdgcn_readfirstlane(tid >> 6);
  const int r = lane & 31, h = lane >> 5;
  f32x16 acc[2][4];
  _Pragma("unroll") for (int i = 0; i < 2; ++i) _Pragma("unroll") for (int j = 0; j < 4; ++j) acc[i][j] = zero16();
  const int lrow = tid >> 3, lcc = tid & 7;
  const bf16_t* Ag = A + (size_t)(m0 + lrow) * lda + lcc * 8;
  const bf16_t* Bg = Bt + (size_t)(n0 + lrow) * ldb + lcc * 8;
  u32x4 ra[8], rb[4];
  _Pragma("unroll") for (int i = 0; i < 8; ++i) ra[i] = *(const u32x4*)(Ag + (size_t)(32 * i) * lda);
  _Pragma("unroll") for (int i = 0; i < 4; ++i) rb[i] = *(const u32x4*)(Bg + (size_t)(32 * i) * ldb);
  const int nk = K >> 6;
  for (int kt = 0; kt < nk; ++kt) {
    __syncthreads();
    _Pragma("unroll") for (int i = 0; i < 8; ++i) *(u32x4*)(sA + (lrow + 32 * i) * GS + lcc * 8) = ra[i];
    _Pragma("unroll") for (int i = 0; i < 4; ++i) *(u32x4*)(sB + (lrow + 32 * i) * GS + lcc * 8) = rb[i];
    __syncthreads();
    if (kt + 1 < nk) {
      _Pragma("unroll") for (int i = 0; i < 8; ++i) ra[i] = *(const u32x4*)(Ag + (size_t)(32 * i) * lda + (kt + 1) * 64);
      _Pragma("unroll") for (int i = 0; i < 4; ++i) rb[i] = *(const u32x4*)(Bg + (size_t)(32 * i) * ldb + (kt + 1) * 64);
    }
    _Pragma("unroll") for (int kk = 0; kk < 4; ++kk) {
      bf16x8 a0 = *(const bf16x8*)(sA + (wave * 64 + r) * GS + kk * 16 + h * 8);
      bf16x8 a1 = *(const bf16x8*)(sA + (wave * 64 + 32 + r) * GS + kk * 16 + h * 8);
      _Pragma("unroll") for (int ni = 0; ni < 4; ++ni) {
        bf16x8 b = *(const bf16x8*)(sB + (ni * 32 + r) * GS + kk * 16 + h * 8);
        acc[0][ni] = MFMA32(a0, b, acc[0][ni]);
        acc[1][ni] = MFMA32(a1, b, acc[1][ni]);
      }
    }
  }
  __syncthreads();
  epi(acc, wave, r, h);
}

constexpr int CS = 136;
DI void stage_vals(bf16_t* sC, const f32x16 (&acc)[2][2], int wm, int wn, int r, int h) {
  _Pragma("unroll") for (int mi = 0; mi < 2; ++mi) _Pragma("unroll") for (int ni = 0; ni < 2; ++ni)
    _Pragma("unroll") for (int reg = 0; reg < 16; ++reg)
      sC[(wm * 64 + mi * 32 + crow(reg, h)) * CS + wn * 64 + ni * 32 + r] = f2bf(acc[mi][ni][reg]);
}
template <class W>
DI void drain_rows(const bf16_t* sC, W&& wr) {
  const int tid = otid();
  _Pragma("unroll") for (int i = 0; i < 8; ++i) {
    int c = tid + 256 * i, row = c >> 4, cc = c & 15;
    u32x4 v = *(const u32x4*)(sC + row * CS + cc * 8);
    wr(row, cc * 8, v);
  }
}

DI void transpose_tile(const float* __restrict__ src, int N, bf16_t* __restrict__ dst, int K, const float* __restrict__ g,
                       int kt, int nt, int mode, char* smem) {
  bf16_t* t = (bf16_t*)smem;
  const int tid = otid(), tx = tid & 63, ty = tid >> 6;
  const int k0 = kt * 64, n0 = nt * 64;
  int nd = n0 + tx, sc = nd;
  bool ok = true;
  if (mode == 1) {
    if (nd < 3264) sc = nd; else if (nd < 4288) sc = nd + 16; else if (nd < 4304) sc = nd - 4288 + 3264; else ok = false;
  }
  __syncthreads();
  float v[16], gv[16];
  if (!ok) sc = 0;
  _Pragma("unroll") for (int i = 0; i < 16; ++i) v[i] = src[(size_t)(k0 + ty + 4 * i) * N + sc];
  if (g) { _Pragma("unroll") for (int i = 0; i < 16; ++i) gv[i] = g[k0 + ty + 4 * i]; }
  else   { _Pragma("unroll") for (int i = 0; i < 16; ++i) gv[i] = 1.f; }
  _Pragma("unroll") for (int i = 0; i < 16; ++i) t[tx * 72 + ty + 4 * i] = f2bf(ok ? v[i] * gv[i] : 0.f);
  __syncthreads();
  const int nl = tid >> 2, kc = (tid & 3) * 16;
  u32x4 v0 = *(const u32x4*)(t + nl * 72 + kc), v1 = *(const u32x4*)(t + nl * 72 + kc + 8);
  bf16_t* d = dst + (size_t)(n0 + nl) * K + k0 + kc;
  *(u32x4*)d = v0; *(u32x4*)(d + 8) = v1;
}

DI void phase0(const Params& p, char* smem) {
  const int nb = gridDim.x, bid = blockIdx.x, tid = otid();
  if (bid == 0 && tid < 64) p.counters[tid] = 0;
  float* red = (float*)smem;
  for (int it = bid; it < 192; it += nb) {
    const int col = it * 16 + (tid & 15), kg = tid >> 4;
    const float* w = p.w_ada + (size_t)(kg * 64) * 3072 + col;
    float s = 0.f;
    _Pragma("unroll") for (int k = 0; k < 64; ++k) s += p.c[kg * 64 + k] * w[(size_t)k * 3072];
    __syncthreads();
    red[tid] = s;
    __syncthreads();
    if (tid < 16) {
      float t = p.b_ada[col];
      _Pragma("unroll") for (int j = 0; j < 16; ++j) t += red[j * 16 + tid];
      p.mod[col] = t;
    }
  }
}

DI void phase0b(const Params& p, char* smem) {
  const int nb = gridDim.x, bid = blockIdx.x, tid = otid();
  constexpr int I_U = 512, I_WIN = 68 * 16, I_WQB = 24 * 6, I_WKV = 32 * 4, I_WOUT = 16 * 32, I_ROPE = 512;
  constexpr int TOTAL = I_U + I_WIN + I_WQB + I_WKV + I_WOUT + I_ROPE;
  for (int it0 = bid; it0 < TOTAL; it0 += nb) {
    int it = it0;
    if (it < I_U) {
      int c0 = (tid & 127) * 8; const int rsub = tid >> 7;
      asm volatile("" : "+v"(c0));
      float sc[8], sh[8];
      _Pragma("unroll") for (int e = 0; e < 8; ++e) {
        sh[e] = p.mod[c0 + e]; sc[e] = 1.f + p.mod[1024 + c0 + e];
      }
      _Pragma("unroll 1") for (int i0 = 0; i0 < 16; i0 += 8) {
        float4 xa[8], xb[8];
        _Pragma("unroll") for (int j = 0; j < 8; ++j) {
          const float4* xp = (const float4*)(p.x + (size_t)(it * 32 + 2 * (i0 + j) + rsub) * 1024 + c0);
          xa[j] = xp[0]; xb[j] = xp[1];
        }
        _Pragma("unroll") for (int j = 0; j < 8; ++j) {
          const float4 a = xa[j], b = xb[j];
          u32x4 o;
          o.x = pk2(a.x * sc[0] + sh[0], a.y * sc[1] + sh[1]);
          o.y = pk2(a.z * sc[2] + sh[2], a.w * sc[3] + sh[3]);
          o.z = pk2(b.x * sc[4] + sh[4], b.y * sc[5] + sh[5]);
          o.w = pk2(b.z * sc[6] + sh[6], b.w * sc[7] + sh[7]);
          *(u32x4*)(p.u + (size_t)(it * 32 + 2 * (i0 + j) + rsub) * 1024 + c0) = o;
        }
      }
      continue;
    }
    it -= I_U;
    if (it < I_WIN) { transpose_tile(p.w_in, 4304, p.w_inT, 1024, nullptr, it % 16, it / 16, 1, smem); continue; }
    it -= I_WIN;
    if (it < I_WQB) { transpose_tile(p.w_qb, 1536, p.w_qbT, 384, p.q_g, it % 6, it / 6, 0, smem); continue; }
    it -= I_WQB;
    if (it < I_WKV) { transpose_tile(p.w_kvb, 2048, p.w_kvbT, 256, p.kv_g, it % 4, it / 4, 0, smem); continue; }
    it -= I_WKV;
    if (it < I_WOUT) { transpose_tile(p.w_out, 1024, p.w_outT, 2048, nullptr, it % 32, it / 32, 0, smem); continue; }
    it -= I_WOUT;
    _Pragma("unroll") for (int j = 0; j < 4; ++j) {
      int e = (it * 4 + j) * 256 + tid, sidx = e >> 5, i = e & 31;
      float ang = (float)p.pos[sidx] * p.inv_freq[i];
      double t = (double)ang * 0.15915494309189535;
      t -= rint(t);
      float f = (float)t;
      p.cs[e] = make_float2(__builtin_amdgcn_cosf(f), __builtin_amdgcn_sinf(f));
    }
  }
}

DI void route_store(const Params& p, size_t rg, int n, u32x4 v) {
  bf16_t* d;
  if (n < 704) d = p.lat + rg * 704 + n;
  else if (n < 1728) d = p.mix + rg * 2048 + (n - 704);
  else if (n < 3264) d = p.xbc + rg * 1536 + (n - 1728);
  else if (n < 4288) d = p.mix + rg * 2048 + 1024 + (n - 3264);
  else return;
  *(u32x4*)d = v;
}
DI void phase1(const Params& p, char* smem) {
  const int xl = blockIdx.x & 7, local = blockIdx.x >> 3, nl = gridDim.x >> 3;
  for (int t = local; t < 256; t += nl) {
    const int m0 = (8 * xl + (t & 7)) * 256, n0 = (t >> 3) * 128;
    gemm256(p.u, 1024, p.w_inT, 1024, 1024, m0, n0, smem,
      [&](const f32x16 (&acc)[2][4], int w, int r, int h) {
        bf16_t* sC = (bf16_t*)smem;
        _Pragma("unroll") for (int ni = 0; ni < 4; ++ni) {
          const int col = n0 + ni * 32 + r;
          if (col >= 4288 && col < 4304) {
            _Pragma("unroll") for (int mi = 0; mi < 2; ++mi) _Pragma("unroll") for (int reg = 0; reg < 16; ++reg)
              p.dt_raw[(size_t)(m0 + w * 64 + mi * 32 + crow(reg, h)) * 16 + (col - 4288)] = acc[mi][ni][reg];
          }
        }
        _Pragma("unroll") for (int half = 0; half < 2; ++half) {
          if ((w >> 1) == half) {
            _Pragma("unroll") for (int mi = 0; mi < 2; ++mi) _Pragma("unroll") for (int ni = 0; ni < 4; ++ni)
              _Pragma("unroll") for (int reg = 0; reg < 16; ++reg)
                sC[((w & 1) * 64 + mi * 32 + crow(reg, h)) * CS + ni * 32 + r] = f2bf(acc[mi][ni][reg]);
          }
          __syncthreads();
          drain_rows(sC, [&](int row, int col, u32x4 v) { route_store(p, (size_t)(m0 + 128 * half + row), n0 + col, v); });
          __syncthreads();
        }
      });
  }
  for (int sidx = local; sidx < 32; sidx += nl) {
    const int t = 256 + (sidx >> 1);
    const int m0 = (8 * xl + (t & 7)) * 256 + (sidx & 1) * 128, n0 = (t >> 3) * 128;
    gemm128(p.u, 1024, p.w_inT, 1024, 1024, m0, n0, smem,
      [&](const f32x16 (&acc)[2][2], int wm, int wn, int r, int h) {
        bf16_t* sC = (bf16_t*)smem;
        _Pragma("unroll") for (int ni = 0; ni < 2; ++ni) {
          int col = n0 + wn * 64 + ni * 32 + r;
          if (col >= 4288 && col < 4304) {
            _Pragma("unroll") for (int mi = 0; mi < 2; ++mi) _Pragma("unroll") for (int reg = 0; reg < 16; ++reg)
              p.dt_raw[(size_t)(m0 + wm * 64 + mi * 32 + crow(reg, h)) * 16 + (col - 4288)] = acc[mi][ni][reg];
          }
        }
        stage_vals(sC, acc, wm, wn, r, h);
        __syncthreads();
        drain_rows(sC, [&](int row, int col, u32x4 v) { route_store(p, (size_t)(m0 + row), n0 + col, v); });
      });
  }
}

DI void row_rnorm(const bf16_t* __restrict__ A, int lda, int K, int m0, float* rn) {
  const int tid = otid(), row = tid >> 1, half = tid & 1;
  const bf16_t* a = A + (size_t)(m0 + row) * lda + half * (K >> 1);
  float s = 0.f;
  for (int i = 0; i < (K >> 4); ++i) {
    u32x4 v = *(const u32x4*)(a + i * 8);
    float f;
    f = bflo(v.x); s += f * f; f = bfhi(v.x); s += f * f;
    f = bflo(v.y); s += f * f; f = bfhi(v.y); s += f * f;
    f = bflo(v.z); s += f * f; f = bfhi(v.z); s += f * f;
    f = bflo(v.w); s += f * f; f = bfhi(v.w); s += f * f;
  }
  s += __shfl_xor(s, 1);
  if (half == 0) rn[row] = rsqrtf(s / (float)K + 1e-6f);
}

DI void q_tile(const Params& p, int it, char* smem) {
  const int m0 = (it / 12) * 128, n0 = (it % 12) * 128;
  float* rn = (float*)(smem + 40960);
  gemm128<true>(p.lat, 704, p.w_qbT, 384, 384, m0, n0, smem,
    [&](const f32x16 (&acc)[2][2], int wm, int wn, int r, int h) {
      bf16_t* sC = (bf16_t*)smem;
      const int nbase = n0 + wn * 64;
      const bool rope = (nbase % 192) == 128;
      float2 csv[2][16];
      if (rope) {
        _Pragma("unroll") for (int mi = 0; mi < 2; ++mi) _Pragma("unroll") for (int reg = 0; reg < 16; ++reg)
          csv[mi][reg] = p.cs[(size_t)(m0 + wm * 64 + mi * 32 + crow(reg, h)) * 32 + r];
      }
      _Pragma("unroll") for (int mi = 0; mi < 2; ++mi) _Pragma("unroll") for (int reg = 0; reg < 16; ++reg) {
        const int rl = wm * 64 + mi * 32 + crow(reg, h);
        const float sc = rn[rl] * QSCALE;
        float v0 = acc[mi][0][reg] * sc, v1 = acc[mi][1][reg] * sc;
        if (rope) {
          float2 cs = csv[mi][reg];
          float o0 = v0 * cs.x - v1 * cs.y, o1 = v1 * cs.x + v0 * cs.y;
          v0 = o0; v1 = o1;
        }
        sC[rl * CS + wn * 64 + r] = f2bf(v0);
        sC[rl * CS + wn * 64 + 32 + r] = f2bf(v1);
      }
      __syncthreads();
      drain_rows(sC, [&](int row, int col, u32x4 v) {
        const int n = n0 + col, head = n / 192, d = n - head * 192;
        *(u32x4*)(p.Q + ((size_t)head * S + m0 + row) * 192 + d) = v;
      });
    }, rn);
}

DI void kv_tile(const Params& p, int it, char* smem) {
  const int m0 = (it >> 4) * 128, nt = it & 15, n0 = nt * 128;
  const int head = nt >> 1, kind = nt & 1;
  float* rn = (float*)(smem + 40960);
  gemm128<true>(p.lat + 384, 704, p.w_kvbT, 256, 256, m0, n0, smem,
    [&](const f32x16 (&acc)[2][2], int wm, int wn, int r, int h) {
      if (kind == 0) {
        bf16_t* sC = (bf16_t*)smem;
        _Pragma("unroll") for (int mi = 0; mi < 2; ++mi) _Pragma("unroll") for (int reg = 0; reg < 16; ++reg) {
          const int rl = wm * 64 + mi * 32 + crow(reg, h);
          const float sc = rn[rl];
          sC[rl * CS + wn * 64 + r] = f2bf(acc[mi][0][reg] * sc);
          sC[rl * CS + wn * 64 + 32 + r] = f2bf(acc[mi][1][reg] * sc);
        }
        __syncthreads();
        drain_rows(sC, [&](int row, int col, u32x4 v) {
          *(u32x4*)(p.Kk + ((size_t)head * S + m0 + row) * 192 + col) = v;
        });
      } else {
        _Pragma("unroll") for (int mi = 0; mi < 2; ++mi) _Pragma("unroll") for (int ni = 0; ni < 2; ++ni) {
          f32x16 t;
          _Pragma("unroll") for (int reg = 0; reg < 16; ++reg) t[reg] = acc[mi][ni][reg] * rn[wm * 64 + mi * 32 + crow(reg, h)];
          const int dv = wn * 64 + ni * 32 + r;
          bf16_t* d = p.VT + ((size_t)head * 128 + dv) * S + m0 + wm * 64 + mi * 32 + 8 * h;
          *(bf16x8*)(d) = pack8(t, 0);
          *(bf16x8*)(d + 16) = pack8(t, 1);
        }
      }
    }, rn);
}

DI void krope_item(const Params& p, int it) {
  const int tid = otid(), tok = it * 128 + (tid >> 1), half = tid & 1;
  const bf16_t* src = p.lat + (size_t)tok * 704 + 640 + half * 16;
  u32x4 a0 = *(const u32x4*)src, a1 = *(const u32x4*)(src + 8), b0 = *(const u32x4*)(src + 32), b1 = *(const u32x4*)(src + 40);
  unsigned xa[8] = {a0.x, a0.y, a0.z, a0.w, a1.x, a1.y, a1.z, a1.w};
  unsigned xb[8] = {b0.x, b0.y, b0.z, b0.w, b1.x, b1.y, b1.z, b1.w};
  unsigned o1[8], o2[8];
  _Pragma("unroll") for (int e = 0; e < 8; ++e) {
    float2 c0 = p.cs[(size_t)tok * 32 + half * 16 + 2 * e], c1 = p.cs[(size_t)tok * 32 + half * 16 + 2 * e + 1];
    float x1a = bflo(xa[e]), x1b = bfhi(xa[e]), x2a = bflo(xb[e]), x2b = bfhi(xb[e]);
    o1[e] = pk2(x1a * c0.x - x2a * c0.y, x1b * c1.x - x2b * c1.y);
    o2[e] = pk2(x2a * c0.x + x1a * c0.y, x2b * c1.x + x1b * c1.y);
  }
  _Pragma("unroll") for (int hd = 0; hd < 8; ++hd) {
    bf16_t* d = p.Kk + ((size_t)hd * S + tok) * 192 + 128 + half * 16;
    *(u32x4*)d = (u32x4){o1[0], o1[1], o1[2], o1[3]}; *(u32x4*)(d + 8) = (u32x4){o1[4], o1[5], o1[6], o1[7]};
    *(u32x4*)(d + 32) = (u32x4){o2[0], o2[1], o2[2], o2[3]}; *(u32x4*)(d + 40) = (u32x4){o2[4], o2[5], o2[6], o2[7]};
  }
}

template <int NT, class F>
DI void conv8(const Params& p, int tok0, int col, F&& f) {
  float w[4][8], bias[8];
  _Pragma("unroll") for (int i = 0; i < 4; ++i) {
    float4 a = *(const float4*)(p.conv_w + i * 1536 + col), b = *(const float4*)(p.conv_w + i * 1536 + col + 4);
    w[i][0] = a.x; w[i][1] = a.y; w[i][2] = a.z; w[i][3] = a.w; w[i][4] = b.x; w[i][5] = b.y; w[i][6] = b.z; w[i][7] = b.w;
  }
  { float4 a = *(const float4*)(p.conv_b + col), b = *(const float4*)(p.conv_b + col + 4);
    bias[0] = a.x; bias[1] = a.y; bias[2] = a.z; bias[3] = a.w; bias[4] = b.x; bias[5] = b.y; bias[6] = b.z; bias[7] = b.w; }
  float wf[4][8];
  _Pragma("unroll") for (int i = 0; i < 3; ++i) {
    int t = tok0 - 3 + i;
    u32x4 q4 = (t >= 0) ? *(const u32x4*)(p.xbc + (size_t)t * 1536 + col) : (u32x4){0, 0, 0, 0};
    wf[i][0] = bflo(q4.x); wf[i][1] = bfhi(q4.x); wf[i][2] = bflo(q4.y); wf[i][3] = bfhi(q4.y);
    wf[i][4] = bflo(q4.z); wf[i][5] = bfhi(q4.z); wf[i][6] = bflo(q4.w); wf[i][7] = bfhi(q4.w);
  }
  u32x4 nxt[NT];
  _Pragma("unroll") for (int j = 0; j < NT; ++j) nxt[j] = *(const u32x4*)(p.xbc + (size_t)(tok0 + j) * 1536 + col);
  _Pragma("unroll") for (int j = 0; j < NT; ++j) {
    const u32x4 q4 = nxt[j];
    wf[3][0] = bflo(q4.x); wf[3][1] = bfhi(q4.x); wf[3][2] = bflo(q4.y); wf[3][3] = bfhi(q4.y);
    wf[3][4] = bflo(q4.z); wf[3][5] = bfhi(q4.z); wf[3][6] = bflo(q4.w); wf[3][7] = bfhi(q4.w);
    float v[8];
    _Pragma("unroll") for (int e = 0; e < 8; ++e) {
      float acc = bias[e];
      _Pragma("unroll") for (int i = 0; i < 4; ++i) acc += w[i][e] * wf[i][e];
      v[e] = silu_f(acc);
    }
    f(j, v);
    _Pragma("unroll") for (int e = 0; e < 8; ++e) { wf[0][e] = wf[1][e]; wf[1][e] = wf[2][e]; wf[2][e] = wf[3][e]; }
  }
}

DI void ssd1_dtscan(const Params& p, int c, int head, int lane, float* fac) {
  const int t0 = c * 128;
  const float A = -__expf(p.a_log[head]), bias = p.dt_bias[head];
  float d0 = softplus_f(p.dt_raw[(size_t)(t0 + 2 * lane) * 16 + head] + bias);
  float d1 = softplus_f(p.dt_raw[(size_t)(t0 + 2 * lane + 1) * 16 + head] + bias);
  float s0 = d0 * A, s1 = s0 + d1 * A;
  float v = s1;
  _Pragma("unroll") for (int off = 1; off < 64; off <<= 1) { float n = __shfl_up(v, off); if (lane >= off) v += n; }
  const float excl = v - s1, aend = __shfl(v, 63);
  fac[2 * lane] = d0 * __expf(aend - (excl + s0));
  fac[2 * lane + 1] = d1 * __expf(aend - (excl + s1));
  if (lane == 0) p.cdecay[c * 16 + head] = __expf(aend);
}
DI void ssd1_item(const Params& p, int it, char* smem) {
  const int c = it >> 1, g = it & 1, t0 = c * 128;
  const int tid = otid(), lane = tid & 63, wave = __builtin_amdgcn_readfirstlane(tid >> 6), r = lane & 31, h = lane >> 5;
  float* fac = (float*)smem;
  bf16_t* BT = (bf16_t*)(smem + 1024);
  bf16_t* XT = BT + 128 * CS;
  __syncthreads();
  if (wave == 2) ssd1_dtscan(p, c, 8 * g, lane, fac);
  {
    const int cc = tid & 15, tg = tid >> 4, tl0 = tg * 8;
    unsigned pkd[8][4];
    conv8<8>(p, t0 + tl0, 1024 + 128 * g + 8 * cc, [&](int j, const float (&v)[8]) {
      _Pragma("unroll") for (int e = 0; e < 8; ++e) {
        unsigned b = f2bf(v[e]);
        if (j & 1) pkd[e][j >> 1] |= b << 16; else pkd[e][j >> 1] = b;
      }
    });
    _Pragma("unroll") for (int e = 0; e < 8; ++e)
      *(u32x4*)(BT + (8 * cc + e) * CS + tl0) = (u32x4){pkd[e][0], pkd[e][1], pkd[e][2], pkd[e][3]};
  }
  for (int hh = 0; hh < 8; ++hh) {
    const int head = 8 * g + hh;
    __syncthreads();
    if (wave < 2) {
      const int cc = tid & 7, tg = tid >> 3, tl0 = tg * 8;
      const float* fc = fac + (hh & 1) * 128 + tl0;
      unsigned pkd[8][4];
      conv8<8>(p, t0 + tl0, 64 * head + 8 * cc, [&](int j, const float (&v)[8]) {
        const float fsc = fc[j];
        _Pragma("unroll") for (int e = 0; e < 8; ++e) {
          unsigned b = f2bf(v[e] * fsc);
          if (j & 1) pkd[e][j >> 1] |= b << 16; else pkd[e][j >> 1] = b;
        }
      });
      _Pragma("unroll") for (int e = 0; e < 8; ++e)
        *(u32x4*)(XT + (8 * cc + e) * CS + tl0) = (u32x4){pkd[e][0], pkd[e][1], pkd[e][2], pkd[e][3]};
    } else if (wave == 2 && hh < 7) {
      ssd1_dtscan(p, c, head + 1, lane, fac + ((hh + 1) & 1) * 128);
    }
    __syncthreads();
    f32x16 acc[2] = {zero16(), zero16()};
    _Pragma("unroll") for (int kk = 0; kk < 8; ++kk) {
      bf16x8 b = *(const bf16x8*)(BT + (32 * wave + r) * CS + 16 * kk + 8 * h);
      bf16x8 a0 = *(const bf16x8*)(XT + r * CS + 16 * kk + 8 * h);
      bf16x8 a1 = *(const bf16x8*)(XT + (32 + r) * CS + 16 * kk + 8 * h);
      acc[0] = MFMA32(a0, b, acc[0]);
      acc[1] = MFMA32(a1, b, acc[1]);
    }
    bf16_t* st = p.states + (size_t)(c * 16 + head) * 8192;
    _Pragma("unroll") for (int pt = 0; pt < 2; ++pt) _Pragma("unroll") for (int reg = 0; reg < 16; ++reg)
      st[(32 * pt + crow(reg, h)) * 128 + 32 * wave + r] = f2bf(acc[pt][reg]);
  }
}

DI void phase2(const Params& p, char* smem) {
  constexpr int I_Q = 128 * 12, I_KV = 128 * 16, I_KR = 128, I_S1 = 256;
  int* sitem = (int*)(smem + SMEM_BYTES - 16);
  for (;;) {
    __syncthreads();
    if (threadIdx.x == 0) *sitem = atomicAdd(p.counters + 16, 1);
    __syncthreads();
    int it = *sitem;
    if (it >= I_Q + I_KV + I_KR + I_S1) break;
    if (it < I_S1) { ssd1_item(p, it, smem); continue; }
    it -= I_S1;
    if (it < I_Q) { q_tile(p, it, smem); continue; }
    it -= I_Q;
    if (it < I_KV) { kv_tile(p, it, smem); continue; }
    it -= I_KV;
    krope_item(p, it);
  }
}

DI void phase3(const Params& p) {
  const int gt = blockIdx.x * NTHREADS + threadIdx.x, nt = gridDim.x * NTHREADS;
  for (int e2 = gt; e2 < 65536; e2 += nt) {
    const int head = e2 >> 12;
    unsigned* base = (unsigned*)p.states + e2;
    float h0 = 0.f, h1 = 0.f;
    for (int c0 = 0; c0 < 128; c0 += 8) {
      unsigned v[8]; float dc[8];
      _Pragma("unroll") for (int j = 0; j < 8; ++j) { v[j] = base[(size_t)(c0 + j) * 65536]; dc[j] = p.cdecay[(c0 + j) * 16 + head]; }
      _Pragma("unroll") for (int j = 0; j < 8; ++j) {
        base[(size_t)(c0 + j) * 65536] = pk2(h0, h1);
        h0 = h0 * dc[j] + bflo(v[j]); h1 = h1 * dc[j] + bfhi(v[j]);
      }
    }
  }
}

constexpr int KS = 200;
constexpr int VS = 72;
DI void attn_item(const Params& p, int qb, int head, char* smem) {
  bf16_t* sK = (bf16_t*)smem;
  bf16_t* sV = sK + 64 * KS;
  const int tid = otid(), lane = tid & 63, wave = __builtin_amdgcn_readfirstlane(tid >> 6), r = lane & 31, h = lane >> 5;
  const int q0 = qb * 128, a = q0 + 32 * wave;
  const bf16_t* Kh = p.Kk + (size_t)head * S * 192;
  const bf16_t* Vh = p.VT + (size_t)head * 128 * S;
  __builtin_amdgcn_s_setprio(2);
  bf16x8 qf[12];
  {
    const bf16_t* qp = p.Q + ((size_t)head * S + a + r) * 192 + 8 * h;
    _Pragma("unroll") for (int kk = 0; kk < 12; ++kk) qf[kk] = *(const bf16x8*)(qp + 16 * kk);
  }
  f32x16 o[4];
  _Pragma("unroll") for (int d = 0; d < 4; ++d) o[d] = zero16();
  float m = -INFINITY, l = 0.f;
  const int ntiles = 2 * qb + 2;
  u32x4 rk[6], rv[4];
  auto gload = [&](int kt) {
    _Pragma("unroll") for (int i = 0; i < 6; ++i) {
      int c = tid + 256 * i, row = c / 24, cc = c - row * 24;
      rk[i] = *(const u32x4*)(Kh + (size_t)(64 * kt + row) * 192 + cc * 8);
    }
    _Pragma("unroll") for (int i = 0; i < 4; ++i) {
      int c = tid + 256 * i, row = c >> 3, cc = c & 7;
      rv[i] = *(const u32x4*)(Vh + (size_t)row * S + 64 * kt + cc * 8);
    }
  };
  gload(0);
  for (int kt = 0; kt < ntiles; ++kt) {
    __syncthreads();
    _Pragma("unroll") for (int i = 0; i < 6; ++i) {
      int c = tid + 256 * i, row = c / 24, cc = c - row * 24;
      *(u32x4*)(sK + row * KS + cc * 8) = rk[i];
    }
    _Pragma("unroll") for (int i = 0; i < 4; ++i) {
      int c = tid + 256 * i, row = c >> 3, cc = c & 7;
      *(u32x4*)(sV + row * VS + cc * 8) = rv[i];
    }
    __syncthreads();
    gload(kt + 1 < ntiles ? kt + 1 : kt);
    asm volatile("" ::: "memory");
    if (64 * kt <= a + 31) {
      f32x16 s[2] = {zero16(), zero16()};
      _Pragma("unroll") for (int kk = 0; kk < 12; ++kk) {
        bf16x8 k0 = *(const bf16x8*)(sK + r * KS + 16 * kk + 8 * h);
        bf16x8 k1 = *(const bf16x8*)(sK + (32 + r) * KS + 16 * kk + 8 * h);
        s[0] = MFMA32(k0, qf[kk], s[0]);
        s[1] = MFMA32(k1, qf[kk], s[1]);
      }
      if (64 * kt + 63 > a) {
        const int qi = a + r;
        _Pragma("unroll") for (int t = 0; t < 2; ++t) _Pragma("unroll") for (int reg = 0; reg < 16; ++reg) {
          const int key = 64 * kt + 32 * t + crow(reg, h);
          if (key > qi) s[t][reg] = -INFINITY;
        }
      }
      float mx = s[0][0];
      _Pragma("unroll") for (int t = 0; t < 2; ++t) _Pragma("unroll") for (int reg = 0; reg < 16; ++reg) mx = fmaxf(mx, s[t][reg]);
      mx = xhalf_max(mx);
      const float mn = fmaxf(m, mx);
      const float alpha = __builtin_amdgcn_exp2f(m - mn);
      m = mn;
      float ps = 0.f;
      _Pragma("unroll") for (int t = 0; t < 2; ++t) _Pragma("unroll") for (int reg = 0; reg < 16; ++reg) {
        float e = __builtin_amdgcn_exp2f(s[t][reg] - mn);
        s[t][reg] = e; ps += e;
      }
      l = l * alpha + ps;
      _Pragma("unroll") for (int d = 0; d < 4; ++d) _Pragma("unroll") for (int reg = 0; reg < 16; ++reg) o[d][reg] *= alpha;
      bf16x8 pf[4];
      pf[0] = pack8(s[0], 0); pf[1] = pack8(s[0], 1); pf[2] = pack8(s[1], 0); pf[3] = pack8(s[1], 1);
      _Pragma("unroll") for (int ks = 0; ks < 4; ++ks) _Pragma("unroll") for (int d = 0; d < 4; ++d) {
        bf16x8 vf = *(const bf16x8*)(sV + (32 * d + r) * VS + 16 * ks + 8 * h);
        o[d] = MFMA32(vf, pf[ks], o[d]);
      }
    }
  }
  __builtin_amdgcn_s_setprio(0);
  l += __shfl_xor(l, 32);
  const float inv = 1.f / l;
  bf16_t* mrow = p.mix + (size_t)(a + r) * 2048 + head * 128 + 4 * h;
  _Pragma("unroll") for (int d = 0; d < 4; ++d) {
   u32x2 zv[4];
   _Pragma("unroll") for (int g4 = 0; g4 < 4; ++g4) zv[g4] = *(const u32x2*)(mrow + 32 * d + 8 * g4);
   _Pragma("unroll") for (int g4 = 0; g4 < 4; ++g4) {
    bf16_t* zp = mrow + 32 * d + 8 * g4;
    u32x2 z = zv[g4];
    float z0 = bflo(z.x), z1 = bfhi(z.x), z2 = bflo(z.y), z3 = bfhi(z.y);
    u32x2 w;
    w.x = pk2(o[d][4 * g4 + 0] * inv * silu_f(z0), o[d][4 * g4 + 1] * inv * silu_f(z1));
    w.y = pk2(o[d][4 * g4 + 2] * inv * silu_f(z2), o[d][4 * g4 + 3] * inv * silu_f(z3));
    *(u32x2*)zp = w;
   }
  }
}

DI void ssd2_item(const Params& p, int it, char* smem) {
  const int c = it >> 1, g = it & 1, t0 = c * 128;
  const int tid = otid(), lane = tid & 63, wave = __builtin_amdgcn_readfirstlane(tid >> 6), r = lane & 31, h = lane >> 5;
  float* acum = (float*)smem;
  float* dtv = acum + 1024;
  bf16_t* Cf = (bf16_t*)(smem + 8192);
  bf16_t* R = Cf + 128 * CS;
  bf16_t* Bs = R;
  bf16_t* XT = R;
  __syncthreads();
  {
    const int hh = tid >> 5, l32 = tid & 31, head = 8 * g + hh;
    const float A = -__expf(p.a_log[head]), bias = p.dt_bias[head];
    float d[4], cs[4];
    _Pragma("unroll") for (int j = 0; j < 4; ++j) d[j] = softplus_f(p.dt_raw[(size_t)(t0 + 4 * l32 + j) * 16 + head] + bias);
    cs[0] = d[0] * A; cs[1] = cs[0] + d[1] * A; cs[2] = cs[1] + d[2] * A; cs[3] = cs[2] + d[3] * A;
    float v = cs[3];
    _Pragma("unroll") for (int off = 1; off < 32; off <<= 1) { float n = __shfl_up(v, off, 32); if (l32 >= off) v += n; }
    const float excl = v - cs[3];
    _Pragma("unroll") for (int j = 0; j < 4; ++j) { acum[hh * 128 + 4 * l32 + j] = excl + cs[j]; dtv[hh * 128 + 4 * l32 + j] = d[j]; }
  }
  if (tid < 128) {
    const int cc = tid & 15, tg = tid >> 4;
    _Pragma("unroll 1") for (int half = 0; half < 2; ++half)
      conv8<8>(p, t0 + tg * 16 + half * 8, 1280 + 128 * g + 8 * cc, [&](int j, const float (&v)[8]) {
        *(u32x4*)(Cf + (tg * 16 + half * 8 + j) * CS + 8 * cc) = (u32x4){pk2(v[0], v[1]), pk2(v[2], v[3]), pk2(v[4], v[5]), pk2(v[6], v[7])};
      });
  }
  f32x16 cbT[4];
  _Pragma("unroll") for (int st = 0; st < 4; ++st) cbT[st] = zero16();
  _Pragma("unroll 1") for (int nh = 0; nh < 2; ++nh) {
    __syncthreads();
    if (tid >= 128) {
      const int t2 = tid - 128, cc = t2 & 7, tg = t2 >> 3;
      conv8<8>(p, t0 + tg * 8, 1024 + 128 * g + 64 * nh + 8 * cc, [&](int j, const float (&v)[8]) {
        *(u32x4*)(Bs + (tg * 8 + j) * 72 + 8 * cc) = (u32x4){pk2(v[0], v[1]), pk2(v[2], v[3]), pk2(v[4], v[5]), pk2(v[6], v[7])};
      });
    }
    __syncthreads();
    _Pragma("unroll") for (int kk = 0; kk < 4; ++kk) {
      bf16x8 cfr = *(const bf16x8*)(Cf + (32 * wave + r) * CS + 64 * nh + 16 * kk + 8 * h);
      _Pragma("unroll") for (int st = 0; st < 4; ++st) {
        if (st <= wave) {
          bf16x8 bfr = *(const bf16x8*)(Bs + (32 * st + r) * 72 + 16 * kk + 8 * h);
          cbT[st] = MFMA32(bfr, cfr, cbT[st]);
        }
      }
    }
  }
  const int ll = 32 * wave + r;
  float sumsq = 0.f;
  bf16_t* mrow = p.mix + (size_t)(t0 + ll) * 2048 + 1024 + 512 * g + 4 * h;
  for (int hh = 0; hh < 8; ++hh) {
    const int head = 8 * g + hh;
    u32x2 zv[2][4];
    {
      _Pragma("unroll") for (int pt = 0; pt < 2; ++pt) _Pragma("unroll") for (int g4 = 0; g4 < 4; ++g4) zv[pt][g4] = *(const u32x2*)(mrow + 64 * hh + 32 * pt + 8 * g4);
      asm volatile("" ::: "memory");
    }
    __syncthreads();
    {
      const int cc = tid & 7, tg = tid >> 3;
      const int col = 64 * head + 8 * cc, tl0 = tg * 4;
      unsigned pkd[8][2];
      float vprev[8];
      conv8<4>(p, t0 + tl0, col, [&](int j, const float (&v)[8]) {
        const float fsc = dtv[hh * 128 + tl0 + j];
        _Pragma("unroll") for (int e = 0; e < 8; ++e) {
          if (j & 1) pkd[e][j >> 1] = pk2(vprev[e], v[e] * fsc); else vprev[e] = v[e] * fsc;
        }
      });
      _Pragma("unroll") for (int e = 0; e < 8; ++e) *(u32x2*)(XT + (8 * cc + e) * CS + tl0) = (u32x2){pkd[e][0], pkd[e][1]};
    }
    __syncthreads();
    const float a_l = acum[hh * 128 + ll], dskip = p.d_skip[head] / dtv[hh * 128 + ll];
    int aoff = hh * 128 + 4 * h, dlt = 4 * h - r;
    asm volatile("" : "+v"(aoff), "+v"(dlt));
    f32x16 yT[2] = {zero16(), zero16()};
    {
      const bf16_t* pv = p.states + (size_t)(c * 16 + head) * 8192 + (size_t)r * 128 + 8 * h;
      bf16x8 pvr[2][8];
      _Pragma("unroll") for (int kk = 0; kk < 8; ++kk) { pvr[0][kk] = *(const bf16x8*)(pv + 16 * kk); pvr[1][kk] = *(const bf16x8*)(pv + 32 * 128 + 16 * kk); }
      _Pragma("unroll") for (int kk = 0; kk < 8; ++kk) {
        bf16x8 cfr = *(const bf16x8*)(Cf + (32 * wave + r) * CS + 16 * kk + 8 * h);
        yT[0] = MFMA32(pvr[0][kk], cfr, yT[0]);
        yT[1] = MFMA32(pvr[1][kk], cfr, yT[1]);
      }
      const float ea = __expf(a_l);
      _Pragma("unroll") for (int reg = 0; reg < 16; ++reg) { yT[0][reg] *= ea; yT[1][reg] *= ea; }
    }
    _Pragma("unroll") for (int st = 0; st < 4; ++st) {
      if (st <= wave) {
        f32x16 mt;
        _Pragma("unroll") for (int reg = 0; reg < 16; ++reg) {
          const int creg = 32 * st + (reg & 3) + 8 * (reg >> 2);
          float v = cbT[st][reg] * __expf(fminf(a_l - acum[aoff + creg], 0.f));
          if (st == wave) {
            const int dd = (reg & 3) + 8 * (reg >> 2) + dlt;
            if (dd > 0) v = 0.f;
            if (dd == 0) v += dskip;
          }
          mt[reg] = v;
        }
        _Pragma("unroll") for (int ks = 0; ks < 2; ++ks) {
          bf16x8 pf = pack8(mt, ks);
          _Pragma("unroll") for (int pt = 0; pt < 2; ++pt) {
            const bf16_t* xp = XT + (32 * pt + r) * CS + 32 * st + 16 * ks + 4 * h;
            bf16x4 lo = *(const bf16x4*)xp, hi = *(const bf16x4*)(xp + 8);
            bf16x8 xa = __builtin_shufflevector(lo, hi, 0, 1, 2, 3, 4, 5, 6, 7);
            yT[pt] = MFMA32(xa, pf, yT[pt]);
          }
        }
      }
    }
    _Pragma("unroll") for (int pt = 0; pt < 2; ++pt) _Pragma("unroll") for (int g4 = 0; g4 < 4; ++g4) {
      bf16_t* zp = mrow + 64 * hh + 32 * pt + 8 * g4;
      u32x2 z = zv[pt][g4];
      float zz[4] = {bflo(z.x), bfhi(z.x), bflo(z.y), bfhi(z.y)};
      float hf[4];
      _Pragma("unroll") for (int j = 0; j < 4; ++j) {
        float y = yT[pt][4 * g4 + j];
        hf[j] = y * silu_f(zz[j]);
        sumsq += hf[j] * hf[j];
      }
      u32x2 w; w.x = pk2(hf[0], hf[1]); w.y = pk2(hf[2], hf[3]);
      *(u32x2*)zp = w;
    }
  }
  sumsq += __shfl_xor(sumsq, 32);
  const float rnm = rsqrtf(sumsq * (1.f / 512.f) + 1e-6f);
  const float* gp = p.ssm_g + 512 * g + 4 * h;
  _Pragma("unroll 1") for (int i0 = 0; i0 < 64; i0 += 16) {
    u32x2 zz[16];
    _Pragma("unroll") for (int j = 0; j < 16; ++j) {
      const int i = i0 + j, off = 64 * (i >> 3) + 32 * ((i >> 2) & 1) + 8 * (i & 3);
      zz[j] = *(const u32x2*)(mrow + off);
    }
    _Pragma("unroll") for (int j = 0; j < 16; ++j) {
      const int i = i0 + j, off = 64 * (i >> 3) + 32 * ((i >> 2) & 1) + 8 * (i & 3);
      float4 gg = *(const float4*)(gp + off);
      u32x2 w;
      w.x = pk2(bflo(zz[j].x) * rnm * gg.x, bfhi(zz[j].x) * rnm * gg.y);
      w.y = pk2(bflo(zz[j].y) * rnm * gg.z, bfhi(zz[j].y) * rnm * gg.w);
      *(u32x2*)(mrow + off) = w;
    }
  }
}

DI void phase4(const Params& p, char* smem) {
  int* sitem = (int*)(smem + SMEM_BYTES - 16);
  for (;;) {
    __syncthreads();
    if (threadIdx.x == 0) *sitem = atomicAdd(p.counters, 1);
    __syncthreads();
    const int it = *sitem;
    if (it >= 256 + 1024) break;
    if (it < 256) ssd2_item(p, it, smem);
    else { const int i = it - 256; attn_item(p, 127 - (i >> 3), i & 7, smem); }
  }
}

DI void phase5(const Params& p, char* smem) {
  const int xl = blockIdx.x & 7, local = blockIdx.x >> 3, nl = gridDim.x >> 3;
  for (int t = local; t < 64; t += nl) {
    const int m0 = (8 * xl + (t >> 3)) * 256, n0 = (t & 7) * 128;
    gemm256(p.mix, 2048, p.w_outT, 2048, 2048, m0, n0, smem,
      [&](const f32x16 (&acc)[2][4], int w, int r, int h) {
        _Pragma("unroll") for (int ni = 0; ni < 4; ++ni) {
          const int col = n0 + ni * 32 + r;
          const float gate = p.mod[2048 + col];
          const float* xb = p.x + (size_t)(m0 + w * 64) * 1024;
          float* ob = p.out + (size_t)(m0 + w * 64) * 1024;
          const int loff = 4 * h * 1024 + col;
          _Pragma("unroll") for (int mi = 0; mi < 2; ++mi) {
            float xv[16];
            _Pragma("unroll") for (int reg = 0; reg < 16; ++reg) xv[reg] = xb[(mi * 32 + (reg & 3) + 8 * (reg >> 2)) * 1024 + loff];
            _Pragma("unroll") for (int reg = 0; reg < 16; ++reg)
              ob[(mi * 32 + (reg & 3) + 8 * (reg >> 2)) * 1024 + loff] = DN_ALPHA * xv[reg] + gate * acc[mi][ni][reg];
          }
        }
      });
  }
}

DI void phase6(const Params& p) {
  const int t6 = otid(), lane = t6 & 63, wv = blockIdx.x * 4 + (t6 >> 6), nw = gridDim.x * 4;
  float4 g[4], bb[4];
  _Pragma("unroll") for (int i = 0; i < 4; ++i) { g[i] = ((const float4*)p.ln_g)[lane + 64 * i]; bb[i] = ((const float4*)p.ln_b)[lane + 64 * i]; }
  for (int row0 = 2 * wv; row0 < S; row0 += 2 * nw) {
    float4 v[2][4];
    _Pragma("unroll") for (int j = 0; j < 2; ++j) _Pragma("unroll") for (int i = 0; i < 4; ++i)
      v[j][i] = ((const float4*)(p.out + (size_t)(row0 + j) * 1024))[lane + 64 * i];
    _Pragma("unroll") for (int j = 0; j < 2; ++j) {
      float s = 0.f;
      _Pragma("unroll") for (int i = 0; i < 4; ++i) s += v[j][i].x + v[j][i].y + v[j][i].z + v[j][i].w;
      _Pragma("unroll") for (int o = 32; o > 0; o >>= 1) s += __shfl_xor(s, o);
      const float mu = s * (1.f / 1024.f);
      float q = 0.f;
      _Pragma("unroll") for (int i = 0; i < 4; ++i) {
        float a = v[j][i].x - mu, b = v[j][i].y - mu, c2 = v[j][i].z - mu, d = v[j][i].w - mu;
        q += a * a + b * b + c2 * c2 + d * d;
      }
      _Pragma("unroll") for (int o = 32; o > 0; o >>= 1) q += __shfl_xor(q, o);
      const float rs = rsqrtf(q * (1.f / 1024.f) + 1e-5f);
      float4* rp = (float4*)(p.out + (size_t)(row0 + j) * 1024);
      _Pragma("unroll") for (int i = 0; i < 4; ++i) {
        float4 o4;
        o4.x = (v[j][i].x - mu) * rs * g[i].x + bb[i].x; o4.y = (v[j][i].y - mu) * rs * g[i].y + bb[i].y;
        o4.z = (v[j][i].z - mu) * rs * g[i].z + bb[i].z; o4.w = (v[j][i].w - mu) * rs * g[i].w + bb[i].w;
        rp[lane + 64 * i] = o4;
      }
    }
  }
}

#if MULTI
template <int PH>
__global__ void __launch_bounds__(NTHREADS, 2) phase_kernel(Params p) {
  __shared__ __attribute__((aligned(16))) char smem[SMEM_BYTES];
  if (PH == 0) phase0(p, smem);
  if (PH == 1) phase0b(p, smem);
  if (PH == 2) phase1(p, smem);
  if (PH == 3) phase2(p, smem);
  if (PH == 4) phase3(p);
  if (PH == 5) phase4(p, smem);
  if (PH == 6) phase5(p, smem);
  if (PH == 7) phase6(p);
}
#else
__global__ void __launch_bounds__(NTHREADS, 2) mega_kernel(Params p) {
  __shared__ __attribute__((aligned(16))) char smem[SMEM_BYTES];
  cg::grid_group grid = cg::this_grid();
  volatile LAS unsigned* st = (volatile LAS unsigned*)(smem + SMEM_BYTES - 64);
  if (threadIdx.x == 0) { st[0] = 0u; st[1] = 0u; }
  __syncthreads();
  XcdBarrier xb = xcd_barrier_post(p.bar, st);
  if (p.probe == 0x7fffffff) grid.sync();
  phase0(p, smem);  xcd_barrier(xb);
  phase0b(p, smem); xcd_barrier(xb);
  phase1(p, smem);  xcd_barrier(xb);
  phase2(p, smem);  xcd_barrier(xb);
  phase3(p);        xcd_barrier(xb);
  phase4(p, smem);  xcd_barrier(xb);
  phase5(p, smem);  xcd_barrier(xb);
  phase6(p);
}
#endif

extern "C" void kernel_launch(void* const* d_in, const int* in_sizes, int n_in, void* d_out, int out_size, void* d_ws,
                              size_t ws_size, hipStream_t stream) {
  Params p{};
  p.x = (const float*)d_in[0]; p.c = (const float*)d_in[1]; p.pos = (const int*)d_in[2];
  p.w_ada = (const float*)d_in[3]; p.b_ada = (const float*)d_in[4]; p.w_in = (const float*)d_in[5];
  p.q_g = (const float*)d_in[6]; p.w_qb = (const float*)d_in[7]; p.kv_g = (const float*)d_in[8]; p.w_kvb = (const float*)d_in[9];
  p.conv_w = (const float*)d_in[10]; p.conv_b = (const float*)d_in[11]; p.dt_bias = (const float*)d_in[12];
  p.a_log = (const float*)d_in[13]; p.d_skip = (const float*)d_in[14]; p.ssm_g = (const float*)d_in[15];
  p.w_out = (const float*)d_in[16]; p.ln_g = (const float*)d_in[17]; p.ln_b = (const float*)d_in[18];
  p.out = (float*)d_out;
  char* ws = (char*)d_ws;
  const size_t MB = 1048576;
  p.Q = (bf16_t*)(ws + 0 * MB); p.u = (bf16_t*)(ws + 0 * MB);
  p.Kk = (bf16_t*)(ws + 48 * MB);
  p.lat = (bf16_t*)(ws + 96 * MB);
  p.xbc = (bf16_t*)(ws + 118 * MB);
  p.mix = (bf16_t*)(ws + 166 * MB);
  p.w_inT = (bf16_t*)(ws + 230 * MB);
  p.w_qbT = (bf16_t*)(ws + 239 * MB);
  p.w_kvbT = (bf16_t*)(ws + 241 * MB);
  p.w_outT = (bf16_t*)(ws + 243 * MB);
  p.dt_raw = (float*)(ws + 247 * MB);
  p.cs = (float2*)(ws + 248 * MB);
  p.modp = (float*)(ws + 252 * MB);
  p.mod = (float*)(ws + 252 * MB + 262144);
  p.cdecay = (float*)(ws + 252 * MB + 327680);
  p.counters = (int*)(ws + 252 * MB + 393216);
  p.bar = (unsigned*)(ws + 253 * MB);
  p.states = (bf16_t*)d_out;
  p.VT = (bf16_t*)((char*)d_out + 32 * MB);
  for (int i = 0; i < 32; ++i) p.inv_freq[i] = 1.0f / powf(10000.0f, (float)i / 32.0f);
#if MULTI
  const int G = 512;
  phase_kernel<0><<<G, NTHREADS, 0, stream>>>(p);
  phase_kernel<1><<<G, NTHREADS, 0, stream>>>(p);
  phase_kernel<2><<<G, NTHREADS, 0, stream>>>(p);
  phase_kernel<3><<<G, NTHREADS, 0, stream>>>(p);
  phase_kernel<4><<<G, NTHREADS, 0, stream>>>(p);
  phase_kernel<5><<<G, NTHREADS, 0, stream>>>(p);
  phase_kernel<6><<<G, NTHREADS, 0, stream>>>(p);
  phase_kernel<7><<<G, NTHREADS, 0, stream>>>(p);
#else
  static int grid_blocks = 0;
  if (!grid_blocks) {
    int dev = 0, cus = 0, per_cu = 0;
    hipGetDevice(&dev);
    hipDeviceGetAttribute(&cus, hipDeviceAttributeMultiprocessorCount, dev);
    hipOccupancyMaxActiveBlocksPerMultiprocessor(&per_cu, mega_kernel, NTHREADS, 0);
    if (per_cu > 2) per_cu = 2;
    grid_blocks = cus * per_cu;
  }
  hipMemsetAsync(p.bar, 0, XCD_BAR_WORDS * 4, stream);
  void* args[] = {&p};
  hipError_t e = hipLaunchCooperativeKernel((void*)mega_kernel, dim3(grid_blocks), dim3(NTHREADS), args, 0, stream);
  if (e != hipSuccess) fprintf(stderr, "cooperative launch failed: %s (grid %d)\n", hipGetErrorString(e), grid_blocks);
#endif
}
```

```cpp
#include <hip/hip_runtime.h>
#include <hip/hip_cooperative_groups.h>
#include <cstdio>
#include <cmath>
namespace cg = cooperative_groups;

#ifndef MULTI
#define MULTI 0
#endif

typedef unsigned short bf16_t;
typedef __attribute__((ext_vector_type(8))) short bf16x8;
typedef __attribute__((ext_vector_type(4))) short bf16x4;
typedef __attribute__((ext_vector_type(16))) float f32x16;
typedef __attribute__((ext_vector_type(2))) __bf16 bf2_t;
typedef __attribute__((ext_vector_type(2))) float f2_t;
typedef __attribute__((ext_vector_type(4))) unsigned u32x4;
typedef __attribute__((ext_vector_type(2))) unsigned u32x2;
#define DI __device__ __forceinline__
#define MFMA32(a, b, c) __builtin_amdgcn_mfma_f32_32x32x16_bf16((a), (b), (c), 0, 0, 0)

constexpr int S = 16384;
constexpr int NTHREADS = 256;
constexpr int SMEM_BYTES = 61504;
constexpr float QSCALE = 0.07216878364870322f * 1.4426950408889634f;
constexpr float DN_ALPHA = 1.189207115002721f;

struct Params {
  const float *x, *c; const int* pos;
  const float *w_ada, *b_ada, *w_in, *q_g, *w_qb, *kv_g, *w_kvb, *conv_w, *conv_b, *dt_bias, *a_log, *d_skip, *ssm_g, *w_out, *ln_g, *ln_b;
  float* out;
  bf16_t *u, *lat, *xbc, *mix, *Q, *Kk, *VT, *states, *w_inT, *w_qbT, *w_kvbT, *w_outT;
  float *dt_raw, *modp, *mod, *cdecay;
  float2* cs;
  int* counters;
  unsigned* bar;
  int probe; int pad0;
  float inv_freq[32];
};

DI unsigned pk2(float a, float b) { f2_t v = {a, b}; bf2_t r = __builtin_convertvector(v, bf2_t); return __builtin_bit_cast(unsigned, r); }
DI bf16_t f2bf(float a) { return (bf16_t)(pk2(a, 0.f) & 0xffffu); }
DI float bf2f(unsigned h) { return __uint_as_float(h << 16); }
DI float bflo(unsigned w) { return __uint_as_float(w << 16); }
DI float bfhi(unsigned w) { return __uint_as_float(w & 0xffff0000u); }
DI int crow(int reg, int h) { return (reg & 3) + 8 * (reg >> 2) + 4 * h; }
DI float silu_f(float x) { return x * __builtin_amdgcn_rcpf(1.f + __expf(-x)); }
DI float softplus_f(float x) { return fmaxf(x, 0.f) + log1pf(__expf(-fabsf(x))); }
DI bf16x8 pack8(const f32x16& x, int s) {
  u32x4 p;
  p.x = pk2(x[8 * s + 0], x[8 * s + 1]); p.y = pk2(x[8 * s + 2], x[8 * s + 3]);
  p.z = pk2(x[8 * s + 4], x[8 * s + 5]); p.w = pk2(x[8 * s + 6], x[8 * s + 7]);
  return __builtin_bit_cast(bf16x8, p);
}
DI int otid() { int t = threadIdx.x; asm volatile("" : "+v"(t)); return t; }
DI float xhalf_max(float v) {
  auto r = __builtin_amdgcn_permlane32_swap(__float_as_uint(v), __float_as_uint(v), false, false);
  return fmaxf(__uint_as_float(r[0]), __uint_as_float(r[1]));
}
DI f32x16 zero16() { f32x16 z; _Pragma("unroll") for (int i = 0; i < 16; ++i) z[i] = 0.f; return z; }


#define XB_TMO      128
#define XB_XCNT(j)  (256  + 64 * (j))
#define XB_XSUB(j)  (1280 + 64 * (j))
#define XB_XGEN(j)  (2304 + 64 * (j))
#define XB_TOP      3328
#define XB_TOPGEN   3392
#define XCD_BAR_WORDS 3456
#define XB_SPIN_CAP (1u << 22)
#define LAS __attribute__((address_space(3)))
DI unsigned xb_ld(unsigned* p)              { return __hip_atomic_load(p, __ATOMIC_RELAXED, __HIP_MEMORY_SCOPE_AGENT); }
DI unsigned xb_add(unsigned* p, unsigned v) { return __hip_atomic_fetch_add(p, v, __ATOMIC_RELAXED, __HIP_MEMORY_SCOPE_AGENT); }
DI unsigned xb_xcc_id() { return (unsigned)__builtin_amdgcn_s_getreg((3 << 11) | 20) & 0xFu; }
#define XB_SPIN(cond, bar) do { unsigned _sp = 0; while (cond) { __builtin_amdgcn_s_sleep(1); \
    if ((++_sp & 255u) == 0u) { if (xb_ld(&(bar)[XB_TMO])) break; if (_sp > XB_SPIN_CAP) { atomicAdd(&(bar)[XB_TMO], 1u); break; } } } } while (0)
struct XcdBarrier { unsigned* bar; unsigned x; volatile LAS unsigned* st; };
DI XcdBarrier xcd_barrier_post(unsigned* bar, volatile LAS unsigned* st) {
  XcdBarrier b; b.bar = bar; b.x = xb_xcc_id(); b.st = st;
  if (threadIdx.x == 0) (void)xb_add(&bar[XB_XCNT(b.x)], 1u);
  return b;
}
DI void xcd_barrier_complete(unsigned* bar, unsigned x, unsigned& nloc, unsigned& nx) {
  const unsigned G = gridDim.x * gridDim.y * gridDim.z;
  unsigned sum, cnt, mine, sp = 0u;
  for (;;) {
    sum = 0u; cnt = 0u; mine = 0u;
    _Pragma("unroll") for (unsigned j = 0; j < 16; ++j) { const unsigned c = xb_ld(&bar[XB_XCNT(j)]); sum += c; cnt += (c > 0u) ? 1u : 0u; mine = (j == x) ? c : mine; }
    if (sum == G) break;
    __builtin_amdgcn_s_sleep(1);
    if ((++sp & 255u) == 0u) { if (xb_ld(&bar[XB_TMO])) break; if (sp > XB_SPIN_CAP) { atomicAdd(&bar[XB_TMO], 1u); break; } }
  }
  nloc = mine > 0u ? mine : 1u; nx = cnt > 0u ? cnt : 1u;
}
DI void xcd_barrier(const XcdBarrier& b) {
  asm volatile("s_waitcnt vmcnt(0)" ::: "memory");
  __syncthreads();
  if (threadIdx.x == 0) {
    unsigned* bar = b.bar;
    __builtin_amdgcn_s_waitcnt(0);
    unsigned nloc = b.st[0], nx = b.st[1];
    if (nloc == 0u) { xcd_barrier_complete(bar, b.x, nloc, nx); b.st[0] = nloc; b.st[1] = nx; }
    const unsigned old = xb_add(&bar[XB_XSUB(b.x)], 1u);
    const unsigned gen = old / nloc;
    if (old + 1u == (gen + 1u) * nloc) {
      __builtin_amdgcn_fence(__ATOMIC_RELEASE, "agent");
      asm volatile("s_waitcnt vmcnt(0)" ::: "memory");
      const unsigned og = xb_add(&bar[XB_TOP], 1u);
      const unsigned tg = og / nx;
      if (og + 1u == (tg + 1u) * nx) xb_add(&bar[XB_TOPGEN], 1u);
      else XB_SPIN(xb_ld(&bar[XB_TOPGEN]) == tg, bar);
      __builtin_amdgcn_fence(__ATOMIC_ACQUIRE, "agent");
      xb_add(&bar[XB_XGEN(b.x)], 1u);
      asm volatile("s_waitcnt vmcnt(0)" ::: "memory");
    } else {
      XB_SPIN(xb_ld(&bar[XB_XGEN(b.x)]) == gen, bar);
      __builtin_amdgcn_fence(__ATOMIC_ACQUIRE, "agent");
      asm volatile("s_waitcnt vmcnt(0)" ::: "memory");
    }
  }
  __syncthreads();
}

constexpr int GS = 72;
DI float sumsq8(u32x4 v) {
  float s = 0.f, f;
  f = bflo(v.x); s += f * f; f = bfhi(v.x); s += f * f;
  f = bflo(v.y); s += f * f; f = bfhi(v.y); s += f * f;
  f = bflo(v.z); s += f * f; f = bfhi(v.z); s += f * f;
  f = bflo(v.w); s += f * f; f = bfhi(v.w); s += f * f;
  return s;
}
template <bool SS = false, class Epi>
DI void gemm128(const bf16_t* __restrict__ A, int lda, const bf16_t* __restrict__ Bt, int ldb, int K, int m0, int n0,
                char* smem, Epi&& epi, float* rn = nullptr) {
  bf16_t* sA = (bf16_t*)smem;
  bf16_t* sB = sA + 128 * GS;
  const int tid = otid(), lane = tid & 63, wave = __builtin_amdgcn_readfirstlane(tid >> 6);
  const int r = lane & 31, h = lane >> 5;
  const int wm = wave >> 1, wn = wave & 1;
  f32x16 acc[2][2];
  _Pragma("unroll") for (int i = 0; i < 2; ++i) _Pragma("unroll") for (int j = 0; j < 2; ++j) acc[i][j] = zero16();
  const int lrow = tid >> 3, lcc = tid & 7;
  const bf16_t* Ag = A + (size_t)(m0 + lrow) * lda + lcc * 8;
  const bf16_t* Bg = Bt + (size_t)(n0 + lrow) * ldb + lcc * 8;
  u32x4 ra[4], rb[4];
  _Pragma("unroll") for (int i = 0; i < 4; ++i) {
    ra[i] = *(const u32x4*)(Ag + (size_t)(32 * i) * lda);
    rb[i] = *(const u32x4*)(Bg + (size_t)(32 * i) * ldb);
  }
  const int nk = K >> 6;
  float ssq[4] = {0.f, 0.f, 0.f, 0.f};
  for (int kt = 0; kt < nk; ++kt) {
    __syncthreads();
    _Pragma("unroll") for (int i = 0; i < 4; ++i) {
      *(u32x4*)(sA + (lrow + 32 * i) * GS + lcc * 8) = ra[i];
      *(u32x4*)(sB + (lrow + 32 * i) * GS + lcc * 8) = rb[i];
      if (SS) ssq[i] += sumsq8(ra[i]);
    }
    __syncthreads();
    if (kt + 1 < nk) {
      _Pragma("unroll") for (int i = 0; i < 4; ++i) {
        ra[i] = *(const u32x4*)(Ag + (size_t)(32 * i) * lda + (kt + 1) * 64);
        rb[i] = *(const u32x4*)(Bg + (size_t)(32 * i) * ldb + (kt + 1) * 64);
      }
    }
    _Pragma("unroll") for (int kk = 0; kk < 4; ++kk) {
      bf16x8 a0 = *(const bf16x8*)(sA + (wm * 64 + r) * GS + kk * 16 + h * 8);
      bf16x8 a1 = *(const bf16x8*)(sA + (wm * 64 + 32 + r) * GS + kk * 16 + h * 8);
      bf16x8 b0 = *(const bf16x8*)(sB + (wn * 64 + r) * GS + kk * 16 + h * 8);
      bf16x8 b1 = *(const bf16x8*)(sB + (wn * 64 + 32 + r) * GS + kk * 16 + h * 8);
      acc[0][0] = MFMA32(a0, b0, acc[0][0]);
      acc[0][1] = MFMA32(a0, b1, acc[0][1]);
      acc[1][0] = MFMA32(a1, b0, acc[1][0]);
      acc[1][1] = MFMA32(a1, b1, acc[1][1]);
    }
  }
  if (SS) {
    _Pragma("unroll") for (int i = 0; i < 4; ++i) {
      float v = ssq[i];
      v += __shfl_xor(v, 1); v += __shfl_xor(v, 2); v += __shfl_xor(v, 4);
      if (lcc == 0) rn[lrow + 32 * i] = rsqrtf(v / (float)K + 1e-6f);
    }
  }
  __syncthreads();
  epi(acc, wm, wn, r, h);
}

template <class Epi>
DI void gemm256(const bf16_t* __restrict__ A, int lda, const bf16_t* __restrict__ Bt, int ldb, int K, int m0, int n0,
                char* smem, Epi&& epi) {
  bf16_t* sA = (bf16_t*)smem;
  bf16_t* sB = sA + 256 * GS;
  const int tid = otid(), lane = tid & 63, wave = __builtin_amdgcn_readfirstlane(tid >> 6);
  const int r = lane & 31, h = lane >> 5;
  f32x16 acc[2][4];
  _Pragma("unroll") for (int i = 0; i < 2; ++i) _Pragma("unroll") for (int j = 0; j < 4; ++j) acc[i][j] = zero16();
  const int lrow = tid >> 3, lcc = tid & 7;
  const bf16_t* Ag = A + (size_t)(m0 + lrow) * lda + lcc * 8;
  const bf16_t* Bg = Bt + (size_t)(n0 + lrow) * ldb + lcc * 8;
  u32x4 ra[8], rb[4];
  _Pragma("unroll") for (int i = 0; i < 8; ++i) ra[i] = *(const u32x4*)(Ag + (size_t)(32 * i) * lda);
  _Pragma("unroll") for (int i = 0; i < 4; ++i) rb[i] = *(const u32x4*)(Bg + (size_t)(32 * i) * ldb);
  const int nk = K >> 6;
  for (int kt = 0; kt < nk; ++kt) {
    __syncthreads();
    _Pragma("unroll") for (int i = 0; i < 8; ++i) *(u32x4*)(sA + (lrow + 32 * i) * GS + lcc * 8) = ra[i];
    _Pragma("unroll") for (int i = 0; i < 4; ++i) *(u32x4*)(sB + (lrow + 32 * i) * GS + lcc * 8) = rb[i];
    __syncthreads();
    if (kt + 1 < nk) {
      _Pragma("unroll") for (int i = 0; i < 8; ++i) ra[i] = *(const u32x4*)(Ag + (size_t)(32 * i) * lda + (kt + 1) * 64);
      _Pragma("unroll") for (int i = 0; i < 4; ++i) rb[i] = *(const u32x4*)(Bg + (size_t)(32 * i) * ldb + (kt + 1) * 64);
    }
    _Pragma("unroll") for (int kk = 0; kk < 4; ++kk) {
      bf16x8 a0 = *(const bf16x8*)(sA + (wave * 64 + r) * GS + kk * 16 + h * 8);
      bf16x8 a1 = *(const bf16x8*)(sA + (wave * 64 + 32 + r) * GS + kk * 16 + h * 8);
      _Pragma("unroll") for (int ni = 0; ni < 4; ++ni) {
        bf16x8 b = *(const bf16x8*)(sB + (ni * 32 + r) * GS + kk * 16 + h * 8);
        acc[0][ni] = MFMA32(a0, b, acc[0][ni]);
        acc[1][ni] = MFMA32(a1, b, acc[1][ni]);
      }
    }
  }
  __syncthreads();
  epi(acc, wave, r, h);
}

constexpr int CS = 136;
DI void stage_vals(bf16_t* sC, const f32x16 (&acc)[2][2], int wm, int wn, int r, int h) {
  _Pragma("unroll") for (int mi = 0; mi < 2; ++mi) _Pragma("unroll") for (int ni = 0; ni < 2; ++ni)
    _Pragma("unroll") for (int reg = 0; reg < 16; ++reg)
      sC[(wm * 64 + mi * 32 + crow(reg, h)) * CS + wn * 64 + ni * 32 + r] = f2bf(acc[mi][ni][reg]);
}
template <class W>
DI void drain_rows(const bf16_t* sC, W&& wr) {
  const int tid = otid();
  _Pragma("unroll") for (int i = 0; i < 8; ++i) {
    int c = tid + 256 * i, row = c >> 4, cc = c & 15;
    u32x4 v = *(const u32x4*)(sC + row * CS + cc * 8);
    wr(row, cc * 8, v);
  }
}

DI void transpose_tile(const float* __restrict__ src, int N, bf16_t* __restrict__ dst, int K, const float* __restrict__ g,
                       int kt, int nt, int mode, char* smem) {
  bf16_t* t = (bf16_t*)smem;
  const int tid = otid(), tx = tid & 63, ty = tid >> 6;
  const int k0 = kt * 64, n0 = nt * 64;
  int nd = n0 + tx, sc = nd;
  bool ok = true;
  if (mode == 1) {
    if (nd < 3264) sc = nd; else if (nd < 4288) sc = nd + 16; else if (nd < 4304) sc = nd - 4288 + 3264; else ok = false;
  }
  __syncthreads();
  float v[16], gv[16];
  if (!ok) sc = 0;
  _Pragma("unroll") for (int i = 0; i < 16; ++i) v[i] = src[(size_t)(k0 + ty + 4 * i) * N + sc];
  if (g) { _Pragma("unroll") for (int i = 0; i < 16; ++i) gv[i] = g[k0 + ty + 4 * i]; }
  else   { _Pragma("unroll") for (int i = 0; i < 16; ++i) gv[i] = 1.f; }
  _Pragma("unroll") for (int i = 0; i < 16; ++i) t[tx * 72 + ty + 4 * i] = f2bf(ok ? v[i] * gv[i] : 0.f);
  __syncthreads();
  const int nl = tid >> 2, kc = (tid & 3) * 16;
  u32x4 v0 = *(const u32x4*)(t + nl * 72 + kc), v1 = *(const u32x4*)(t + nl * 72 + kc + 8);
  bf16_t* d = dst + (size_t)(n0 + nl) * K + k0 + kc;
  *(u32x4*)d = v0; *(u32x4*)(d + 8) = v1;
}

DI void phase0(const Params& p, char* smem) {
  const int nb = gridDim.x, bid = blockIdx.x, tid = otid();
  if (bid == 0 && tid < 64) p.counters[tid] = 0;
  float* red = (float*)smem;
  for (int it = bid; it < 192; it += nb) {
    const int col = it * 16 + (tid & 15), kg = tid >> 4;
    const float* w = p.w_ada + (size_t)(kg * 64) * 3072 + col;
    float s = 0.f;
    _Pragma("unroll") for (int k = 0; k < 64; ++k) s += p.c[kg * 64 + k] * w[(size_t)k * 3072];
    __syncthreads();
    red[tid] = s;
    __syncthreads();
    if (tid < 16) {
      float t = p.b_ada[col];
      _Pragma("unroll") for (int j = 0; j < 16; ++j) t += red[j * 16 + tid];
      p.mod[col] = t;
    }
  }
}

DI void phase0b(const Params& p, char* smem) {
  const int nb = gridDim.x, bid = blockIdx.x, tid = otid();
  constexpr int I_U = 512, I_WIN = 68 * 16, I_WQB = 24 * 6, I_WKV = 32 * 4, I_WOUT = 16 * 32, I_ROPE = 512;
  constexpr int TOTAL = I_U + I_WIN + I_WQB + I_WKV + I_WOUT + I_ROPE;
  for (int it0 = bid; it0 < TOTAL; it0 += nb) {
    int it = it0;
    if (it < I_U) {
      int c0 = (tid & 127) * 8; const int rsub = tid >> 7;
      asm volatile("" : "+v"(c0));
      float sc[8], sh[8];
      _Pragma("unroll") for (int e = 0; e < 8; ++e) {
        sh[e] = p.mod[c0 + e]; sc[e] = 1.f + p.mod[1024 + c0 + e];
      }
      _Pragma("unroll 1") for (int i0 = 0; i0 < 16; i0 += 8) {
        float4 xa[8], xb[8];
        _Pragma("unroll") for (int j = 0; j < 8; ++j) {
          const float4* xp = (const float4*)(p.x + (size_t)(it * 32 + 2 * (i0 + j) + rsub) * 1024 + c0);
          xa[j] = xp[0]; xb[j] = xp[1];
        }
        _Pragma("unroll") for (int j = 0; j < 8; ++j) {
          const float4 a = xa[j], b = xb[j];
          u32x4 o;
          o.x = pk2(a.x * sc[0] + sh[0], a.y * sc[1] + sh[1]);
          o.y = pk2(a.z * sc[2] + sh[2], a.w * sc[3] + sh[3]);
          o.z = pk2(b.x * sc[4] + sh[4], b.y * sc[5] + sh[5]);
          o.w = pk2(b.z * sc[6] + sh[6], b.w * sc[7] + sh[7]);
          *(u32x4*)(p.u + (size_t)(it * 32 + 2 * (i0 + j) + rsub) * 1024 + c0) = o;
        }
      }
      continue;
    }
    it -= I_U;
    if (it < I_WIN) { transpose_tile(p.w_in, 4304, p.w_inT, 1024, nullptr, it % 16, it / 16, 1, smem); continue; }
    it -= I_WIN;
    if (it < I_WQB) { transpose_tile(p.w_qb, 1536, p.w_qbT, 384, p.q_g, it % 6, it / 6, 0, smem); continue; }
    it -= I_WQB;
    if (it < I_WKV) { transpose_tile(p.w_kvb, 2048, p.w_kvbT, 256, p.kv_g, it % 4, it / 4, 0, smem); continue; }
    it -= I_WKV;
    if (it < I_WOUT) { transpose_tile(p.w_out, 1024, p.w_outT, 2048, nullptr, it % 32, it / 32, 0, smem); continue; }
    it -= I_WOUT;
    _Pragma("unroll") for (int j = 0; j < 4; ++j) {
      int e = (it * 4 + j) * 256 + tid, sidx = e >> 5, i = e & 31;
      float ang = (float)p.pos[sidx] * p.inv_freq[i];
      double t = (double)ang * 0.15915494309189535;
      t -= rint(t);
      float f = (float)t;
      p.cs[e] = make_float2(__builtin_amdgcn_cosf(f), __builtin_amdgcn_sinf(f));
    }
  }
}

DI void route_store(const Params& p, size_t rg, int n, u32x4 v) {
  bf16_t* d;
  if (n < 704) d = p.lat + rg * 704 + n;
  else if (n < 1728) d = p.mix + rg * 2048 + (n - 704);
  else if (n < 3264) d = p.xbc + rg * 1536 + (n - 1728);
  else if (n < 4288) d = p.mix + rg * 2048 + 1024 + (n - 3264);
  else return;
  *(u32x4*)d = v;
}
DI void phase1(const Params& p, char* smem) {
  const int xl = blockIdx.x & 7, local = blockIdx.x >> 3, nl = gridDim.x >> 3;
  for (int t = local; t < 256; t += nl) {
    const int m0 = (8 * xl + (t & 7)) * 256, n0 = (t >> 3) * 128;
    gemm256(p.u, 1024, p.w_inT, 1024, 1024, m0, n0, smem,
      [&](const f32x16 (&acc)[2][4], int w, int r, int h) {
        bf16_t* sC = (bf16_t*)smem;
        _Pragma("unroll") for (int ni = 0; ni < 4; ++ni) {
          const int col = n0 + ni * 32 + r;
          if (col >= 4288 && col < 4304) {
            _Pragma("unroll") for (int mi = 0; mi < 2; ++mi) _Pragma("unroll") for (int reg = 0; reg < 16; ++reg)
              p.dt_raw[(size_t)(m0 + w * 64 + mi * 32 + crow(reg, h)) * 16 + (col - 4288)] = acc[mi][ni][reg];
          }
        }
        _Pragma("unroll") for (int half = 0; half < 2; ++half) {
          if ((w >> 1) == half) {
            _Pragma("unroll") for (int mi = 0; mi < 2; ++mi) _Pragma("unroll") for (int ni = 0; ni < 4; ++ni)
              _Pragma("unroll") for (int reg = 0; reg < 16; ++reg)
                sC[((w & 1) * 64 + mi * 32 + crow(reg, h)) * CS + ni * 32 + r] = f2bf(acc[mi][ni][reg]);
          }
          __syncthreads();
          drain_rows(sC, [&](int row, int col, u32x4 v) { route_store(p, (size_t)(m0 + 128 * half + row), n0 + col, v); });
          __syncthreads();
        }
      });
  }
  for (int sidx = local; sidx < 32; sidx += nl) {
    const int t = 256 + (sidx >> 1);
    const int m0 = (8 * xl + (t & 7)) * 256 + (sidx & 1) * 128, n0 = (t >> 3) * 128;
    gemm128(p.u, 1024, p.w_inT, 1024, 1024, m0, n0, smem,
      [&](const f32x16 (&acc)[2][2], int wm, int wn, int r, int h) {
        bf16_t* sC = (bf16_t*)smem;
        _Pragma("unroll") for (int ni = 0; ni < 2; ++ni) {
          int col = n0 + wn * 64 + ni * 32 + r;
          if (col >= 4288 && col < 4304) {
            _Pragma("unroll") for (int mi = 0; mi < 2; ++mi) _Pragma("unroll") for (int reg = 0; reg < 16; ++reg)
              p.dt_raw[(size_t)(m0 + wm * 64 + mi * 32 + crow(reg, h)) * 16 + (col - 4288)] = acc[mi][ni][reg];
          }
        }
        stage_vals(sC, acc, wm, wn, r, h);
        __syncthreads();
        drain_rows(sC, [&](int row, int col, u32x4 v) { route_store(p, (size_t)(m0 + row), n0 + col, v); });
      });
  }
}

DI void row_rnorm(const bf16_t* __restrict__ A, int lda, int K, int m0, float* rn) {
  const int tid = otid(), row = tid >> 1, half = tid & 1;
  const bf16_t* a = A + (size_t)(m0 + row) * lda + half * (K >> 1);
  float s = 0.f;
  for (int i = 0; i < (K >> 4); ++i) {
    u32x4 v = *(const u32x4*)(a + i * 8);
    float f;
    f = bflo(v.x); s += f * f; f = bfhi(v.x); s += f * f;
    f = bflo(v.y); s += f * f; f = bfhi(v.y); s += f * f;
    f = bflo(v.z); s += f * f; f = bfhi(v.z); s += f * f;
    f = bflo(v.w); s += f * f; f = bfhi(v.w); s += f * f;
  }
  s += __shfl_xor(s, 1);
  if (half == 0) rn[row] = rsqrtf(s / (float)K + 1e-6f);
}

DI void q_tile(const Params& p, int it, char* smem) {
  const int m0 = (it / 12) * 128, n0 = (it % 12) * 128;
  float* rn = (float*)(smem + 40960);
  gemm128<true>(p.lat, 704, p.w_qbT, 384, 384, m0, n0, smem,
    [&](const f32x16 (&acc)[2][2], int wm, int wn, int r, int h) {
      bf16_t* sC = (bf16_t*)smem;
      const int nbase = n0 + wn * 64;
      const bool rope = (nbase % 192) == 128;
      float2 csv[2][16];
      if (rope) {
        _Pragma("unroll") for (int mi = 0; mi < 2; ++mi) _Pragma("unroll") for (int reg = 0; reg < 16; ++reg)
          csv[mi][reg] = p.cs[(size_t)(m0 + wm * 64 + mi * 32 + crow(reg, h)) * 32 + r];
      }
      _Pragma("unroll") for (int mi = 0; mi < 2; ++mi) _Pragma("unroll") for (int reg = 0; reg < 16; ++reg) {
        const int rl = wm * 64 + mi * 32 + crow(reg, h);
        const float sc = rn[rl] * QSCALE;
        float v0 = acc[mi][0][reg] * sc, v1 = acc[mi][1][reg] * sc;
        if (rope) {
          float2 cs = csv[mi][reg];
          float o0 = v0 * cs.x - v1 * cs.y, o1 = v1 * cs.x + v0 * cs.y;
          v0 = o0; v1 = o1;
        }
        sC[rl * CS + wn * 64 + r] = f2bf(v0);
        sC[rl * CS + wn * 64 + 32 + r] = f2bf(v1);
      }
      __syncthreads();
      drain_rows(sC, [&](int row, int col, u32x4 v) {
        const int n = n0 + col, head = n / 192, d = n - head * 192;
        *(u32x4*)(p.Q + ((size_t)head * S + m0 + row) * 192 + d) = v;
      });
    }, rn);
}

DI void kv_tile(const Params& p, int it, char* smem) {
  const int m0 = (it >> 4) * 128, nt = it & 15, n0 = nt * 128;
  const int head = nt >> 1, kind = nt & 1;
  float* rn = (float*)(smem + 40960);
  gemm128<true>(p.lat + 384, 704, p.w_kvbT, 256, 256, m0, n0, smem,
    [&](const f32x16 (&acc)[2][2], int wm, int wn, int r, int h) {
      if (kind == 0) {
        bf16_t* sC = (bf16_t*)smem;
        _Pragma("unroll") for (int mi = 0; mi < 2; ++mi) _Pragma("unroll") for (int reg = 0; reg < 16; ++reg) {
          const int rl = wm * 64 + mi * 32 + crow(reg, h);
          const float sc = rn[rl];
          sC[rl * CS + wn * 64 + r] = f2bf(acc[mi][0][reg] * sc);
          sC[rl * CS + wn * 64 + 32 + r] = f2bf(acc[mi][1][reg] * sc);
        }
        __syncthreads();
        drain_rows(sC, [&](int row, int col, u32x4 v) {
          *(u32x4*)(p.Kk + ((size_t)head * S + m0 + row) * 192 + col) = v;
        });
      } else {
        _Pragma("unroll") for (int mi = 0; mi < 2; ++mi) _Pragma("unroll") for (int ni = 0; ni < 2; ++ni) {
          f32x16 t;
          _Pragma("unroll") for (int reg = 0; reg < 16; ++reg) t[reg] = acc[mi][ni][reg] * rn[wm * 64 + mi * 32 + crow(reg, h)];
          const int dv = wn * 64 + ni * 32 + r;
          bf16_t* d = p.VT + ((size_t)head * 128 + dv) * S + m0 + wm * 64 + mi * 32 + 8 * h;
          *(bf16x8*)(d) = pack8(t, 0);
          *(bf16x8*)(d + 16) = pack8(t, 1);
        }
      }
    }, rn);
}

DI void krope_item(const Params& p, int it) {
  const int tid = otid(), tok = it * 128 + (tid >> 1), half = tid & 1;
  const bf16_t* src = p.lat + (size_t)tok * 704 + 640 + half * 16;
  u32x4 a0 = *(const u32x4*)src, a1 = *(const u32x4*)(src + 8), b0 = *(const u32x4*)(src + 32), b1 = *(const u32x4*)(src + 40);
  unsigned xa[8] = {a0.x, a0.y, a0.z, a0.w, a1.x, a1.y, a1.z, a1.w};
  unsigned xb[8] = {b0.x, b0.y, b0.z, b0.w, b1.x, b1.y, b1.z, b1.w};
  unsigned o1[8], o2[8];
  _Pragma("unroll") for (int e = 0; e < 8; ++e) {
    float2 c0 = p.cs[(size_t)tok * 32 + half * 16 + 2 * e], c1 = p.cs[(size_t)tok * 32 + half * 16 + 2 * e + 1];
    float x1a = bflo(xa[e]), x1b = bfhi(xa[e]), x2a = bflo(xb[e]), x2b = bfhi(xb[e]);
    o1[e] = pk2(x1a * c0.x - x2a * c0.y, x1b * c1.x - x2b * c1.y);
    o2[e] = pk2(x2a * c0.x + x1a * c0.y, x2b * c1.x + x1b * c1.y);
  }
  _Pragma("unroll") for (int hd = 0; hd < 8; ++hd) {
    bf16_t* d = p.Kk + ((size_t)hd * S + tok) * 192 + 128 + half * 16;
    *(u32x4*)d = (u32x4){o1[0], o1[1], o1[2], o1[3]}; *(u32x4*)(d + 8) = (u32x4){o1[4], o1[5], o1[6], o1[7]};
    *(u32x4*)(d + 32) = (u32x4){o2[0], o2[1], o2[2], o2[3]}; *(u32x4*)(d + 40) = (u32x4){o2[4], o2[5], o2[6], o2[7]};
  }
}

template <int NT, class F>
DI void conv8(const Params& p, int tok0, int col, F&& f) {
  float w[4][8], bias[8];
  _Pragma("unroll") for (int i = 0; i < 4; ++i) {
    float4 a = *(const float4*)(p.conv_w + i * 1536 + col), b = *(const float4*)(p.conv_w + i * 1536 + col + 4);
    w[i][0] = a.x; w[i][1] = a.y; w[i][2] = a.z; w[i][3] = a.w; w[i][4] = b.x; w[i][5] = b.y; w[i][6] = b.z; w[i][7] = b.w;
  }
  { float4 a = *(const float4*)(p.conv_b + col), b = *(const float4*)(p.conv_b + col + 4);
    bias[0] = a.x; bias[1] = a.y; bias[2] = a.z; bias[3] = a.w; bias[4] = b.x; bias[5] = b.y; bias[6] = b.z; bias[7] = b.w; }
  float wf[4][8];
  _Pragma("unroll") for (int i = 0; i < 3; ++i) {
    int t = tok0 - 3 + i;
    u32x4 q4 = (t >= 0) ? *(const u32x4*)(p.xbc + (size_t)t * 1536 + col) : (u32x4){0, 0, 0, 0};
    wf[i][0] = bflo(q4.x); wf[i][1] = bfhi(q4.x); wf[i][2] = bflo(q4.y); wf[i][3] = bfhi(q4.y);
    wf[i][4] = bflo(q4.z); wf[i][5] = bfhi(q4.z); wf[i][6] = bflo(q4.w); wf[i][7] = bfhi(q4.w);
  }
  u32x4 nxt[NT];
  _Pragma("unroll") for (int j = 0; j < NT; ++j) nxt[j] = *(const u32x4*)(p.xbc + (size_t)(tok0 + j) * 1536 + col);
  _Pragma("unroll") for (int j = 0; j < NT; ++j) {
    const u32x4 q4 = nxt[j];
    wf[3][0] = bflo(q4.x); wf[3][1] = bfhi(q4.x); wf[3][2] = bflo(q4.y); wf[3][3] = bfhi(q4.y);
    wf[3][4] = bflo(q4.z); wf[3][5] = bfhi(q4.z); wf[3][6] = bflo(q4.w); wf[3][7] = bfhi(q4.w);
    float v[8];
    _Pragma("unroll") for (int e = 0; e < 8; ++e) {
      float acc = bias[e];
      _Pragma("unroll") for (int i = 0; i < 4; ++i) acc += w[i][e] * wf[i][e];
      v[e] = silu_f(acc);
    }
    f(j, v);
    _Pragma("unroll") for (int e = 0; e < 8; ++e) { wf[0][e] = wf[1][e]; wf[1][e] = wf[2][e]; wf[2][e] = wf[3][e]; }
  }
}

DI void ssd1_dtscan(const Params& p, int c, int head, int lane, float* fac) {
  const int t0 = c * 128;
  const float A = -__expf(p.a_log[head]), bias = p.dt_bias[head];
  float d0 = softplus_f(p.dt_raw[(size_t)(t0 + 2 * lane) * 16 + head] + bias);
  float d1 = softplus_f(p.dt_raw[(size_t)(t0 + 2 * lane + 1) * 16 + head] + bias);
  float s0 = d0 * A, s1 = s0 + d1 * A;
  float v = s1;
  _Pragma("unroll") for (int off = 1; off < 64; off <<= 1) { float n = __shfl_up(v, off); if (lane >= off) v += n; }
  const float excl = v - s1, aend = __shfl(v, 63);
  fac[2 * lane] = d0 * __expf(aend - (excl + s0));
  fac[2 * lane + 1] = d1 * __expf(aend - (excl + s1));
  if (lane == 0) p.cdecay[c * 16 + head] = __expf(aend);
}
DI void ssd1_item(const Params& p, int it, char* smem) {
  const int c = it >> 1, g = it & 1, t0 = c * 128;
  const int tid = otid(), lane = tid & 63, wave = __builtin_amdgcn_readfirstlane(tid >> 6), r = lane & 31, h = lane >> 5;
  float* fac = (float*)smem;
  bf16_t* BT = (bf16_t*)(smem + 1024);
  bf16_t* XT = BT + 128 * CS;
  __syncthreads();
  if (wave == 2) ssd1_dtscan(p, c, 8 * g, lane, fac);
  {
    const int cc = tid & 15, tg = tid >> 4, tl0 = tg * 8;
    unsigned pkd[8][4];
    conv8<8>(p, t0 + tl0, 1024 + 128 * g + 8 * cc, [&](int j, const float (&v)[8]) {
      _Pragma("unroll") for (int e = 0; e < 8; ++e) {
        unsigned b = f2bf(v[e]);
        if (j & 1) pkd[e][j >> 1] |= b << 16; else pkd[e][j >> 1] = b;
      }
    });
    _Pragma("unroll") for (int e = 0; e < 8; ++e)
      *(u32x4*)(BT + (8 * cc + e) * CS + tl0) = (u32x4){pkd[e][0], pkd[e][1], pkd[e][2], pkd[e][3]};
  }
  for (int hh = 0; hh < 8; ++hh) {
    const int head = 8 * g + hh;
    __syncthreads();
    if (wave < 2) {
      const int cc = tid & 7, tg = tid >> 3, tl0 = tg * 8;
      const float* fc = fac + (hh & 1) * 128 + tl0;
      unsigned pkd[8][4];
      conv8<8>(p, t0 + tl0, 64 * head + 8 * cc, [&](int j, const float (&v)[8]) {
        const float fsc = fc[j];
        _Pragma("unroll") for (int e = 0; e < 8; ++e) {
          unsigned b = f2bf(v[e] * fsc);
          if (j & 1) pkd[e][j >> 1] |= b << 16; else pkd[e][j >> 1] = b;
        }
      });
      _Pragma("unroll") for (int e = 0; e < 8; ++e)
        *(u32x4*)(XT + (8 * cc + e) * CS + tl0) = (u32x4){pkd[e][0], pkd[e][1], pkd[e][2], pkd[e][3]};
    } else if (wave == 2 && hh < 7) {
      ssd1_dtscan(p, c, head + 1, lane, fac + ((hh + 1) & 1) * 128);
    }
    __syncthreads();
    f32x16 acc[2] = {zero16(), zero16()};
    _Pragma("unroll") for (int kk = 0; kk < 8; ++kk) {
      bf16x8 b = *(const bf16x8*)(BT + (32 * wave + r) * CS + 16 * kk + 8 * h);
      bf16x8 a0 = *(const bf16x8*)(XT + r * CS + 16 * kk + 8 * h);
      bf16x8 a1 = *(const bf16x8*)(XT + (32 + r) * CS + 16 * kk + 8 * h);
      acc[0] = MFMA32(a0, b, acc[0]);
      acc[1] = MFMA32(a1, b, acc[1]);
    }
    bf16_t* st = p.states + (size_t)(c * 16 + head) * 8192;
    _Pragma("unroll") for (int pt = 0; pt < 2; ++pt) _Pragma("unroll") for (int reg = 0; reg < 16; ++reg)
      st[(32 * pt + crow(reg, h)) * 128 + 32 * wave + r] = f2bf(acc[pt][reg]);
  }
}

DI void phase2(const Params& p, char* smem) {
  constexpr int I_Q = 128 * 12, I_KV = 128 * 16, I_KR = 128, I_S1 = 256;
  int* sitem = (int*)(smem + SMEM_BYTES - 16);
  for (;;) {
    __syncthreads();
    if (threadIdx.x == 0) *sitem = atomicAdd(p.counters + 16, 1);
    __syncthreads();
    int it = *sitem;
    if (it >= I_Q + I_KV + I_KR + I_S1) break;
    if (it < I_S1) { ssd1_item(p, it, smem); continue; }
    it -= I_S1;
    if (it < I_Q) { q_tile(p, it, smem); continue; }
    it -= I_Q;
    if (it < I_KV) { kv_tile(p, it, smem); continue; }
    it -= I_KV;
    krope_item(p, it);
  }
}

DI void phase3(const Params& p) {
  const int gt = blockIdx.x * NTHREADS + threadIdx.x, nt = gridDim.x * NTHREADS;
  for (int e2 = gt; e2 < 65536; e2 += nt) {
    const int head = e2 >> 12;
    unsigned* base = (unsigned*)p.states + e2;
    float h0 = 0.f, h1 = 0.f;
    for (int c0 = 0; c0 < 128; c0 += 8) {
      unsigned v[8]; float dc[8];
      _Pragma("unroll") for (int j = 0; j < 8; ++j) { v[j] = base[(size_t)(c0 + j) * 65536]; dc[j] = p.cdecay[(c0 + j) * 16 + head]; }
      _Pragma("unroll") for (int j = 0; j < 8; ++j) {
        base[(size_t)(c0 + j) * 65536] = pk2(h0, h1);
        h0 = h0 * dc[j] + bflo(v[j]); h1 = h1 * dc[j] + bfhi(v[j]);
      }
    }
  }
}

constexpr int KS = 200;
constexpr int VS = 72;
DI void attn_item(const Params& p, int qb, int head, char* smem) {
  bf16_t* sK = (bf16_t*)smem;
  bf16_t* sV = sK + 64 * KS;
  const int tid = otid(), lane = tid & 63, wave = __builtin_amdgcn_readfirstlane(tid >> 6), r = lane & 31, h = lane >> 5;
  const int q0 = qb * 128, a = q0 + 32 * wave;
  const bf16_t* Kh = p.Kk + (size_t)head * S * 192;
  const bf16_t* Vh = p.VT + (size_t)head * 128 * S;
  __builtin_amdgcn_s_setprio(2);
  bf16x8 qf[12];
  {
    const bf16_t* qp = p.Q + ((size_t)head * S + a + r) * 192 + 8 * h;
    _Pragma("unroll") for (int kk = 0; kk < 12; ++kk) qf[kk] = *(const bf16x8*)(qp + 16 * kk);
  }
  f32x16 o[4];
  _Pragma("unroll") for (int d = 0; d < 4; ++d) o[d] = zero16();
  float m = -INFINITY, l = 0.f;
  const int ntiles = 2 * qb + 2;
  u32x4 rk[6], rv[4];
  auto gload = [&](int kt) {
    _Pragma("unroll") for (int i = 0; i < 6; ++i) {
      int c = tid + 256 * i, row = c / 24, cc = c - row * 24;
      rk[i] = *(const u32x4*)(Kh + (size_t)(64 * kt + row) * 192 + cc * 8);
    }
    _Pragma("unroll") for (int i = 0; i < 4; ++i) {
      int c = tid + 256 * i, row = c >> 3, cc = c & 7;
      rv[i] = *(const u32x4*)(Vh + (size_t)row * S + 64 * kt + cc * 8);
    }
  };
  gload(0);
  for (int kt = 0; kt < ntiles; ++kt) {
    __syncthreads();
    _Pragma("unroll") for (int i = 0; i < 6; ++i) {
      int c = tid + 256 * i, row = c / 24, cc = c - row * 24;
      *(u32x4*)(sK + row * KS + cc * 8) = rk[i];
    }
    _Pragma("unroll") for (int i = 0; i < 4; ++i) {
      int c = tid + 256 * i, row = c >> 3, cc = c & 7;
      *(u32x4*)(sV + row * VS + cc * 8) = rv[i];
    }
    __syncthreads();
    gload(kt + 1 < ntiles ? kt + 1 : kt);
    asm volatile("" ::: "memory");
    if (64 * kt <= a + 31) {
      f32x16 s[2] = {zero16(), zero16()};
      _Pragma("unroll") for (int kk = 0; kk < 12; ++kk) {
        bf16x8 k0 = *(const bf16x8*)(sK + r * KS + 16 * kk + 8 * h);
        bf16x8 k1 = *(const bf16x8*)(sK + (32 + r) * KS + 16 * kk + 8 * h);
        s[0] = MFMA32(k0, qf[kk], s[0]);
        s[1] = MFMA32(k1, qf[kk], s[1]);
      }
      if (64 * kt + 63 > a) {
        const int qi = a + r;
        _Pragma("unroll") for (int t = 0; t < 2; ++t) _Pragma("unroll") for (int reg = 0; reg < 16; ++reg) {
          const int key = 64 * kt + 32 * t + crow(reg, h);
          if (key > qi) s[t][reg] = -INFINITY;
        }
      }
      float mx = s[0][0];
      _Pragma("unroll") for (int t = 0; t < 2; ++t) _Pragma("unroll") for (int reg = 0; reg < 16; ++reg) mx = fmaxf(mx, s[t][reg]);
      mx = xhalf_max(mx);
      const float mn = fmaxf(m, mx);
      const float alpha = __builtin_amdgcn_exp2f(m - mn);
      m = mn;
      float ps = 0.f;
      _Pragma("unroll") for (int t = 0; t < 2; ++t) _Pragma("unroll") for (int reg = 0; reg < 16; ++reg) {
        float e = __builtin_amdgcn_exp2f(s[t][reg] - mn);
        s[t][reg] = e; ps += e;
      }
      l = l * alpha + ps;
      _Pragma("unroll") for (int d = 0; d < 4; ++d) _Pragma("unroll") for (int reg = 0; reg < 16; ++reg) o[d][reg] *= alpha;
      bf16x8 pf[4];
      pf[0] = pack8(s[0], 0); pf[1] = pack8(s[0], 1); pf[2] = pack8(s[1], 0); pf[3] = pack8(s[1], 1);
      _Pragma("unroll") for (int ks = 0; ks < 4; ++ks) _Pragma("unroll") for (int d = 0; d < 4; ++d) {
        bf16x8 vf = *(const bf16x8*)(sV + (32 * d + r) * VS + 16 * ks + 8 * h);
        o[d] = MFMA32(vf, pf[ks], o[d]);
      }
    }
  }
  __builtin_amdgcn_s_setprio(0);
  l += __shfl_xor(l, 32);
  const float inv = 1.f / l;
  bf16_t* mrow = p.mix + (size_t)(a + r) * 2048 + head * 128 + 4 * h;
  _Pragma("unroll") for (int d = 0; d < 4; ++d) {
   u32x2 zv[4];
   _Pragma("unroll") for (int g4 = 0; g4 < 4; ++g4) zv[g4] = *(const u32x2*)(mrow + 32 * d + 8 * g4);
   _Pragma("unroll") for (int g4 = 0; g4 < 4; ++g4) {
    bf16_t* zp = mrow + 32 * d + 8 * g4;
    u32x2 z = zv[g4];
    float z0 = bflo(z.x), z1 = bfhi(z.x), z2 = bflo(z.y), z3 = bfhi(z.y);
    u32x2 w;
    w.x = pk2(o[d][4 * g4 + 0] * inv * silu_f(z0), o[d][4 * g4 + 1] * inv * silu_f(z1));
    w.y = pk2(o[d][4 * g4 + 2] * inv * silu_f(z2), o[d][4 * g4 + 3] * inv * silu_f(z3));
    *(u32x2*)zp = w;
   }
  }
}

DI void ssd2_item(const Params& p, int it, char* smem) {
  const int c = it >> 1, g = it & 1, t0 = c * 128;
  const int tid = otid(), lane = tid & 63, wave = __builtin_amdgcn_readfirstlane(tid >> 6), r = lane & 31, h = lane >> 5;
  float* acum = (float*)smem;
  float* dtv = acum + 1024;
  bf16_t* Cf = (bf16_t*)(smem + 8192);
  bf16_t* R = Cf + 128 * CS;
  bf16_t* Bs = R;
  bf16_t* XT = R;
  __syncthreads();
  {
    const int hh = tid >> 5, l32 = tid & 31, head = 8 * g + hh;
    const float A = -__expf(p.a_log[head]), bias = p.dt_bias[head];
    float d[4], cs[4];
    _Pragma("unroll") for (int j = 0; j < 4; ++j) d[j] = softplus_f(p.dt_raw[(size_t)(t0 + 4 * l32 + j) * 16 + head] + bias);
    cs[0] = d[0] * A; cs[1] = cs[0] + d[1] * A; cs[2] = cs[1] + d[2] * A; cs[3] = cs[2] + d[3] * A;
    float v = cs[3];
    _Pragma("unroll") for (int off = 1; off < 32; off <<= 1) { float n = __shfl_up(v, off, 32); if (l32 >= off) v += n; }
    const float excl = v - cs[3];
    _Pragma("unroll") for (int j = 0; j < 4; ++j) { acum[hh * 128 + 4 * l32 + j] = excl + cs[j]; dtv[hh * 128 + 4 * l32 + j] = d[j]; }
  }
  if (tid < 128) {
    const int cc = tid & 15, tg = tid >> 4;
    _Pragma("unroll 1") for (int half = 0; half < 2; ++half)
      conv8<8>(p, t0 + tg * 16 + half * 8, 1280 + 128 * g + 8 * cc, [&](int j, const float (&v)[8]) {
        *(u32x4*)(Cf + (tg * 16 + half * 8 + j) * CS + 8 * cc) = (u32x4){pk2(v[0], v[1]), pk2(v[2], v[3]), pk2(v[4], v[5]), pk2(v[6], v[7])};
      });
  }
  f32x16 cbT[4];
  _Pragma("unroll") for (int st = 0; st < 4; ++st) cbT[st] = zero16();
  _Pragma("unroll 1") for (int nh = 0; nh < 2; ++nh) {
    __syncthreads();
    if (tid >= 128) {
      const int t2 = tid - 128, cc = t2 & 7, tg = t2 >> 3;
      conv8<8>(p, t0 + tg * 8, 1024 + 128 * g + 64 * nh + 8 * cc, [&](int j, const float (&v)[8]) {
        *(u32x4*)(Bs + (tg * 8 + j) * 72 + 8 * cc) = (u32x4){pk2(v[0], v[1]), pk2(v[2], v[3]), pk2(v[4], v[5]), pk2(v[6], v[7])};
      });
    }
    __syncthreads();
    _Pragma("unroll") for (int kk = 0; kk < 4; ++kk) {
      bf16x8 cfr = *(const bf16x8*)(Cf + (32 * wave + r) * CS + 64 * nh + 16 * kk + 8 * h);
      _Pragma("unroll") for (int st = 0; st < 4; ++st) {
        if (st <= wave) {
          bf16x8 bfr = *(const bf16x8*)(Bs + (32 * st + r) * 72 + 16 * kk + 8 * h);
          cbT[st] = MFMA32(bfr, cfr, cbT[st]);
        }
      }
    }
  }
  const int ll = 32 * wave + r;
  float sumsq = 0.f;
  bf16_t* mrow = p.mix + (size_t)(t0 + ll) * 2048 + 1024 + 512 * g + 4 * h;
  for (int hh = 0; hh < 8; ++hh) {
    const int head = 8 * g + hh;
    u32x2 zv[2][4];
    {
      _Pragma("unroll") for (int pt = 0; pt < 2; ++pt) _Pragma("unroll") for (int g4 = 0; g4 < 4; ++g4) zv[pt][g4] = *(const u32x2*)(mrow + 64 * hh + 32 * pt + 8 * g4);
      asm volatile("" ::: "memory");
    }
    __syncthreads();
    {
      const int cc = tid & 7, tg = tid >> 3;
      const int col = 64 * head + 8 * cc, tl0 = tg * 4;
      unsigned pkd[8][2];
      float vprev[8];
      conv8<4>(p, t0 + tl0, col, [&](int j, const float (&v)[8]) {
        const float fsc = dtv[hh * 128 + tl0 + j];
        _Pragma("unroll") for (int e = 0; e < 8; ++e) {
          if (j & 1) pkd[e][j >> 1] = pk2(vprev[e], v[e] * fsc); else vprev[e] = v[e] * fsc;
        }
      });
      _Pragma("unroll") for (int e = 0; e < 8; ++e) *(u32x2*)(XT + (8 * cc + e) * 140 + tl0) = (u32x2){pkd[e][0], pkd[e][1]};
    }
    __syncthreads();
    const float a_l = acum[hh * 128 + ll], dskip = p.d_skip[head] / dtv[hh * 128 + ll];
    int aoff = hh * 128 + 4 * h, dlt = 4 * h - r;
    asm volatile("" : "+v"(aoff), "+v"(dlt));
    f32x16 yT[2] = {zero16(), zero16()};
    {
      const bf16_t* pv = p.states + (size_t)(c * 16 + head) * 8192 + (size_t)r * 128 + 8 * h;
      bf16x8 pvr[2][8];
      _Pragma("unroll") for (int kk = 0; kk < 8; ++kk) { pvr[0][kk] = *(const bf16x8*)(pv + 16 * kk); pvr[1][kk] = *(const bf16x8*)(pv + 32 * 128 + 16 * kk); }
      _Pragma("unroll") for (int kk = 0; kk < 8; ++kk) {
        bf16x8 cfr = *(const bf16x8*)(Cf + (32 * wave + r) * CS + 16 * kk + 8 * h);
        yT[0] = MFMA32(pvr[0][kk], cfr, yT[0]);
        yT[1] = MFMA32(pvr[1][kk], cfr, yT[1]);
      }
      const float ea = __expf(a_l);
      _Pragma("unroll") for (int reg = 0; reg < 16; ++reg) { yT[0][reg] *= ea; yT[1][reg] *= ea; }
    }
    _Pragma("unroll") for (int st = 0; st < 4; ++st) {
      if (st <= wave) {
        f32x16 mt;
        _Pragma("unroll") for (int reg = 0; reg < 16; ++reg) {
          const int creg = 32 * st + (reg & 3) + 8 * (reg >> 2);
          float v = cbT[st][reg] * __expf(fminf(a_l - acum[aoff + creg], 0.f));
          if (st == wave) {
            const int dd = (reg & 3) + 8 * (reg >> 2) + dlt;
            if (dd > 0) v = 0.f;
            if (dd == 0) v += dskip;
          }
          mt[reg] = v;
        }
        _Pragma("unroll") for (int ks = 0; ks < 2; ++ks) {
          bf16x8 pf = pack8(mt, ks);
          _Pragma("unroll") for (int pt = 0; pt < 2; ++pt) {
            const bf16_t* xp = XT + (32 * pt + r) * 140 + 32 * st + 16 * ks + 4 * h;
            bf16x4 lo = *(const bf16x4*)xp, hi = *(const bf16x4*)(xp + 8);
            bf16x8 xa = __builtin_shufflevector(lo, hi, 0, 1, 2, 3, 4, 5, 6, 7);
            yT[pt] = MFMA32(xa, pf, yT[pt]);
          }
        }
      }
    }
    _Pragma("unroll") for (int pt = 0; pt < 2; ++pt) _Pragma("unroll") for (int g4 = 0; g4 < 4; ++g4) {
      bf16_t* zp = mrow + 64 * hh + 32 * pt + 8 * g4;
      u32x2 z = zv[pt][g4];
      float zz[4] = {bflo(z.x), bfhi(z.x), bflo(z.y), bfhi(z.y)};
      float hf[4];
      _Pragma("unroll") for (int j = 0; j < 4; ++j) {
        float y = yT[pt][4 * g4 + j];
        hf[j] = y * silu_f(zz[j]);
        sumsq += hf[j] * hf[j];
      }
      u32x2 w; w.x = pk2(hf[0], hf[1]); w.y = pk2(hf[2], hf[3]);
      *(u32x2*)zp = w;
    }
  }
  sumsq += __shfl_xor(sumsq, 32);
  const float rnm = rsqrtf(sumsq * (1.f / 512.f) + 1e-6f);
  const float* gp = p.ssm_g + 512 * g + 4 * h;
  _Pragma("unroll 1") for (int i0 = 0; i0 < 64; i0 += 16) {
    u32x2 zz[16];
    _Pragma("unroll") for (int j = 0; j < 16; ++j) {
      const int i = i0 + j, off = 64 * (i >> 3) + 32 * ((i >> 2) & 1) + 8 * (i & 3);
      zz[j] = *(const u32x2*)(mrow + off);
    }
    _Pragma("unroll") for (int j = 0; j < 16; ++j) {
      const int i = i0 + j, off = 64 * (i >> 3) + 32 * ((i >> 2) & 1) + 8 * (i & 3);
      float4 gg = *(const float4*)(gp + off);
      u32x2 w;
      w.x = pk2(bflo(zz[j].x) * rnm * gg.x, bfhi(zz[j].x) * rnm * gg.y);
      w.y = pk2(bflo(zz[j].y) * rnm * gg.z, bfhi(zz[j].y) * rnm * gg.w);
      *(u32x2*)(mrow + off) = w;
    }
  }
}

DI void phase4(const Params& p, char* smem) {
  int* sitem = (int*)(smem + SMEM_BYTES - 16);
  for (;;) {
    __syncthreads();
    if (threadIdx.x == 0) *sitem = atomicAdd(p.counters, 1);
    __syncthreads();
    const int it = *sitem;
    if (it >= 256 + 1024) break;
    if (it < 256) ssd2_item(p, it, smem);
    else { const int i = it - 256; attn_item(p, 127 - (i >> 3), i & 7, smem); }
  }
}

DI void phase5(const Params& p, char* smem) {
  const int xl = blockIdx.x & 7, local = blockIdx.x >> 3, nl = gridDim.x >> 3;
  for (int t = local; t < 64; t += nl) {
    const int m0 = (8 * xl + (t >> 3)) * 256, n0 = (t & 7) * 128;
    gemm256(p.mix, 2048, p.w_outT, 2048, 2048, m0, n0, smem,
      [&](const f32x16 (&acc)[2][4], int w, int r, int h) {
        _Pragma("unroll") for (int ni = 0; ni < 4; ++ni) {
          const int col = n0 + ni * 32 + r;
          const float gate = p.mod[2048 + col];
          const float* xb = p.x + (size_t)(m0 + w * 64) * 1024;
          float* ob = p.out + (size_t)(m0 + w * 64) * 1024;
          const int loff = 4 * h * 1024 + col;
          _Pragma("unroll") for (int mi = 0; mi < 2; ++mi) {
            float xv[16];
            _Pragma("unroll") for (int reg = 0; reg < 16; ++reg) xv[reg] = xb[(mi * 32 + (reg & 3) + 8 * (reg >> 2)) * 1024 + loff];
            _Pragma("unroll") for (int reg = 0; reg < 16; ++reg)
              ob[(mi * 32 + (reg & 3) + 8 * (reg >> 2)) * 1024 + loff] = DN_ALPHA * xv[reg] + gate * acc[mi][ni][reg];
          }
        }
      });
  }
}

DI void phase6(const Params& p) {
  const int t6 = otid(), lane = t6 & 63, wv = blockIdx.x * 4 + (t6 >> 6), nw = gridDim.x * 4;
  float4 g[4], bb[4];
  _Pragma("unroll") for (int i = 0; i < 4; ++i) { g[i] = ((const float4*)p.ln_g)[lane + 64 * i]; bb[i] = ((const float4*)p.ln_b)[lane + 64 * i]; }
  for (int row0 = 2 * wv; row0 < S; row0 += 2 * nw) {
    float4 v[2][4];
    _Pragma("unroll") for (int j = 0; j < 2; ++j) _Pragma("unroll") for (int i = 0; i < 4; ++i)
      v[j][i] = ((const float4*)(p.out + (size_t)(row0 + j) * 1024))[lane + 64 * i];
    _Pragma("unroll") for (int j = 0; j < 2; ++j) {
      float s = 0.f;
      _Pragma("unroll") for (int i = 0; i < 4; ++i) s += v[j][i].x + v[j][i].y + v[j][i].z + v[j][i].w;
      _Pragma("unroll") for (int o = 32; o > 0; o >>= 1) s += __shfl_xor(s, o);
      const float mu = s * (1.f / 1024.f);
      float q = 0.f;
      _Pragma("unroll") for (int i = 0; i < 4; ++i) {
        float a = v[j][i].x - mu, b = v[j][i].y - mu, c2 = v[j][i].z - mu, d = v[j][i].w - mu;
        q += a * a + b * b + c2 * c2 + d * d;
      }
      _Pragma("unroll") for (int o = 32; o > 0; o >>= 1) q += __shfl_xor(q, o);
      const float rs = rsqrtf(q * (1.f / 1024.f) + 1e-5f);
      float4* rp = (float4*)(p.out + (size_t)(row0 + j) * 1024);
      _Pragma("unroll") for (int i = 0; i < 4; ++i) {
        float4 o4;
        o4.x = (v[j][i].x - mu) * rs * g[i].x + bb[i].x; o4.y = (v[j][i].y - mu) * rs * g[i].y + bb[i].y;
        o4.z = (v[j][i].z - mu) * rs * g[i].z + bb[i].z; o4.w = (v[j][i].w - mu) * rs * g[i].w + bb[i].w;
        rp[lane + 64 * i] = o4;
      }
    }
  }
}

#if MULTI
template <int PH>
__global__ void __launch_bounds__(NTHREADS, 2) phase_kernel(Params p) {
  __shared__ __attribute__((aligned(16))) char smem[SMEM_BYTES];
  if (PH == 0) phase0(p, smem);
  if (PH == 1) phase0b(p, smem);
  if (PH == 2) phase1(p, smem);
  if (PH == 3) phase2(p, smem);
  if (PH == 4) phase3(p);
  if (PH == 5) phase4(p, smem);
  if (PH == 6) phase5(p, smem);
  if (PH == 7) phase6(p);
}
#else
__global__ void __launch_bounds__(NTHREADS, 2) mega_kernel(Params p) {
  __shared__ __attribute__((aligned(16))) char smem[SMEM_BYTES];
  cg::grid_group grid = cg::this_grid();
  volatile LAS unsigned* st = (volatile LAS unsigned*)(smem + SMEM_BYTES - 64);
  if (threadIdx.x == 0) { st[0] = 0u; st[1] = 0u; }
  __syncthreads();
  XcdBarrier xb = xcd_barrier_post(p.bar, st);
  if (p.probe == 0x7fffffff) grid.sync();
  phase0(p, smem);  xcd_barrier(xb);
  phase0b(p, smem); xcd_barrier(xb);
  phase1(p, smem);  xcd_barrier(xb);
  phase2(p, smem);  xcd_barrier(xb);
  phase3(p);        xcd_barrier(xb);
  phase4(p, smem);  xcd_barrier(xb);
  phase5(p, smem);  xcd_barrier(xb);
  phase6(p);
}
#endif

extern "C" void kernel_launch(void* const* d_in, const int* in_sizes, int n_in, void* d_out, int out_size, void* d_ws,
                              size_t ws_size, hipStream_t stream) {
  Params p{};
  p.x = (const float*)d_in[0]; p.c = (const float*)d_in[1]; p.pos = (const int*)d_in[2];
  p.w_ada = (const float*)d_in[3]; p.b_ada = (const float*)d_in[4]; p.w_in = (const float*)d_in[5];
  p.q_g = (const float*)d_in[6]; p.w_qb = (const float*)d_in[7]; p.kv_g = (const float*)d_in[8]; p.w_kvb = (const float*)d_in[9];
  p.conv_w = (const float*)d_in[10]; p.conv_b = (const float*)d_in[11]; p.dt_bias = (const float*)d_in[12];
  p.a_log = (const float*)d_in[13]; p.d_skip = (const float*)d_in[14]; p.ssm_g = (const float*)d_in[15];
  p.w_out = (const float*)d_in[16]; p.ln_g = (const float*)d_in[17]; p.ln_b = (const float*)d_in[18];
  p.out = (float*)d_out;
  char* ws = (char*)d_ws;
  const size_t MB = 1048576;
  p.Q = (bf16_t*)(ws + 0 * MB); p.u = (bf16_t*)(ws + 0 * MB);
  p.Kk = (bf16_t*)(ws + 48 * MB);
  p.lat = (bf16_t*)(ws + 96 * MB);
  p.xbc = (bf16_t*)(ws + 118 * MB);
  p.mix = (bf16_t*)(ws + 166 * MB);
  p.w_inT = (bf16_t*)(ws + 230 * MB);
  p.w_qbT = (bf16_t*)(ws + 239 * MB);
  p.w_kvbT = (bf16_t*)(ws + 241 * MB);
  p.w_outT = (bf16_t*)(ws + 243 * MB);
  p.dt_raw = (float*)(ws + 247 * MB);
  p.cs = (float2*)(ws + 248 * MB);
  p.modp = (float*)(ws + 252 * MB);
  p.mod = (float*)(ws + 252 * MB + 262144);
  p.cdecay = (float*)(ws + 252 * MB + 327680);
  p.counters = (int*)(ws + 252 * MB + 393216);
  p.bar = (unsigned*)(ws + 253 * MB);
  p.states = (bf16_t*)d_out;
  p.VT = (bf16_t*)((char*)d_out + 32 * MB);
  for (int i = 0; i < 32; ++i) p.inv_freq[i] = 1.0f / powf(10000.0f, (float)i / 32.0f);
#if MULTI
  const int G = 512;
  phase_kernel<0><<<G, NTHREADS, 0, stream>>>(p);
  phase_kernel<1><<<G, NTHREADS, 0, stream>>>(p);
  phase_kernel<2><<<G, NTHREADS, 0, stream>>>(p);
  phase_kernel<3><<<G, NTHREADS, 0, stream>>>(p);
  phase_kernel<4><<<G, NTHREADS, 0, stream>>>(p);
  phase_kernel<5><<<G, NTHREADS, 0, stream>>>(p);
  phase_kernel<6><<<G, NTHREADS, 0, stream>>>(p);
  phase_kernel<7><<<G, NTHREADS, 0, stream>>>(p);
#else
  static int grid_blocks = 0;
  if (!grid_blocks) {
    int dev = 0, cus = 0, per_cu = 0;
    hipGetDevice(&dev);
    hipDeviceGetAttribute(&cus, hipDeviceAttributeMultiprocessorCount, dev);
    hipOccupancyMaxActiveBlocksPerMultiprocessor(&per_cu, mega_kernel, NTHREADS, 0);
    if (per_cu > 2) per_cu = 2;
    grid_blocks = cus * per_cu;
  }
  hipMemsetAsync(p.bar, 0, XCD_BAR_WORDS * 4, stream);
  void* args[] = {&p};
  hipError_t e = hipLaunchCooperativeKernel((void*)mega_kernel, dim3(grid_blocks), dim3(NTHREADS), args, 0, stream);
  if (e != hipSuccess) fprintf(stderr, "cooperative launch failed: %s (grid %d)\n", hipGetErrorString(e), grid_blocks);
#endif
}
```
